# Optimizing an MI355X kernel written in HIP

```python
import jax, jax.numpy as jnp
from jax import lax
import numpy as np

D_MODEL = 1024
BATCH = 1
SEQ = 16384
DEPTH = 2

N_MIXERS = 2
ROPE_THETA = 500000.0
Q_BLOCK = 128
NEG_INF = -1e30
LN_EPS = 1e-5
RMS_EPS = 1e-6
MLA_HEADS = 8
MLA_Q_RANK = 384
MLA_KV_RANK = 256
MLA_NOPE_DIM = 128
MLA_ROPE_DIM = 64
MLA_V_DIM = 128
MLA_QK_DIM = MLA_NOPE_DIM + MLA_ROPE_DIM
MOBA_HEADS = 8
MOBA_HEAD_DIM = D_MODEL // MOBA_HEADS
MOBA_ROT_DIM = MOBA_HEAD_DIM // 4
MOBA_BLOCK = 256
MOBA_TOPK = 3
MOBA_Q_CHUNK = 32
D_FF = -(-(8 * D_MODEL) // (3 * 256)) * 256
DEEPNORM_ALPHA = (2 * DEPTH) ** 0.25
DEEPNORM_BETA = (8 * DEPTH) ** -0.25
N_MLA_LAYERS = (DEPTH + 1) // 2
N_MOBA_LAYERS = DEPTH // 2

kernel_name = "hybrid_mla_moba_deepnorm"


def layer_norm(x, g, b):
    xf = x.astype(jnp.float32)
    mu = xf.mean(-1, keepdims=True)
    var = jnp.square(xf - mu).mean(-1, keepdims=True)
    return ((xf - mu) * lax.rsqrt(var + LN_EPS) * g + b).astype(x.dtype)


def rms_norm(x, g):
    xf = x.astype(jnp.float32)
    return (xf * lax.rsqrt(jnp.square(xf).mean(-1, keepdims=True) + RMS_EPS) * g).astype(x.dtype)


def rotary_tables(seq_len, rot_dim):
    inv_freq = ROPE_THETA ** (-jnp.arange(0, rot_dim, 2, dtype=jnp.float32) / rot_dim)
    ang = jnp.arange(seq_len, dtype=jnp.float32)[:, None] * inv_freq[None, :]
    return jnp.cos(ang), jnp.sin(ang)


def apply_rope(x, cos, sin):
    x1, x2 = jnp.split(x, 2, axis=-1)
    out = jnp.concatenate([x1 * cos - x2 * sin, x2 * cos + x1 * sin], axis=-1)
    return out.astype(x.dtype)


def partial_rope(x, cos, sin):
    return jnp.concatenate([apply_rope(x[..., :MOBA_ROT_DIM], cos, sin), x[..., MOBA_ROT_DIM:]], axis=-1)


def mla_mixer(x, cos, sin, w_dqkv, q_norm, w_uq, kv_norm, w_ukv, w_o):
    B, S, _ = x.shape
    H = MLA_HEADS
    lat = x @ w_dqkv
    c_q, c_kv, k_rope = jnp.split(lat, [MLA_Q_RANK, MLA_Q_RANK + MLA_KV_RANK], axis=-1)
    q = (rms_norm(c_q, q_norm) @ w_uq).reshape(B, S, H, MLA_QK_DIM).transpose(0, 2, 1, 3)
    q_nope = q[..., :MLA_NOPE_DIM]
    q_rope = apply_rope(q[..., MLA_NOPE_DIM:], cos, sin)
    k_rope = apply_rope(k_rope, cos, sin)
    kv = (rms_norm(c_kv, kv_norm) @ w_ukv).reshape(B, S, H, MLA_NOPE_DIM + MLA_V_DIM).transpose(0, 2, 1, 3)
    k_nope, v = kv[..., :MLA_NOPE_DIM], kv[..., MLA_NOPE_DIM:]
    scale = MLA_QK_DIM ** -0.5
    kpos = jnp.arange(S)

    def attend_block(i):
        start = i * Q_BLOCK
        qn = lax.dynamic_slice_in_dim(q_nope, start, Q_BLOCK, axis=2)
        qr = lax.dynamic_slice_in_dim(q_rope, start, Q_BLOCK, axis=2)
        s = (jnp.einsum('bhqd,bhkd->bhqk', qn, k_nope)
             + jnp.einsum('bhqr,bkr->bhqk', qr, k_rope)).astype(jnp.float32) * scale
        qpos = start + jnp.arange(Q_BLOCK)
        s = jnp.where(kpos[None, :] <= qpos[:, None], s, NEG_INF)
        p = jax.nn.softmax(s, axis=-1).astype(v.dtype)
        return jnp.einsum('bhqk,bhkv->bhqv', p, v)

    out = lax.map(attend_block, jnp.arange(S // Q_BLOCK))
    out = out.transpose(1, 0, 3, 2, 4).reshape(B, S, H * MLA_V_DIM)
    return out @ w_o


def moba_mixer(x, cos, sin, w_qkv, w_o):
    B, S, _ = x.shape
    H, Dh = MOBA_HEADS, MOBA_HEAD_DIM
    qkv = (x @ w_qkv).reshape(B, S, 3, H, Dh).transpose(2, 0, 3, 1, 4)
    q = partial_rope(qkv[0], cos, sin)
    k = partial_rope(qkv[1], cos, sin)
    v = qkv[2]
    nb = max(-(-S // MOBA_BLOCK), MOBA_TOPK)
    pad = nb * MOBA_BLOCK - S
    k_blocks = jnp.pad(k, ((0, 0), (0, 0), (0, pad), (0, 0))).reshape(B, H, nb, MOBA_BLOCK, Dh)
    v_blocks = jnp.pad(v, ((0, 0), (0, 0), (0, pad), (0, 0))).reshape(B, H, nb, MOBA_BLOCK, Dh)
    k_mean = k_blocks.astype(jnp.float32).mean(axis=3).astype(k.dtype)
    scale = Dh ** -0.5
    bi = jnp.arange(B)[:, None, None, None]
    hi = jnp.arange(H)[None, :, None, None]
    blk_ids = jnp.arange(nb)
    offs = jnp.arange(MOBA_BLOCK)
    n_sel = MOBA_TOPK * MOBA_BLOCK

    def attend_chunk(i):
        start = i * MOBA_Q_CHUNK
        qc = lax.dynamic_slice_in_dim(q, start, MOBA_Q_CHUNK, axis=2)
        qpos = start + jnp.arange(MOBA_Q_CHUNK)
        own = start // MOBA_BLOCK
        gate = jnp.einsum('bhqd,bhnd->bhqn', qc, k_mean).astype(jnp.float32)
        gate = jnp.where(blk_ids < own, gate, NEG_INF)
        _, sel = lax.top_k(gate, MOBA_TOPK)
        sel_valid = sel < own
        k_sel = k_blocks[bi, hi, sel]
        v_sel = v_blocks[bi, hi, sel]
        s_sel = jnp.einsum('bhqd,bhqnkd->bhqnk', qc, k_sel).astype(jnp.float32) * scale
        s_sel = jnp.where(sel_valid[..., None], s_sel, NEG_INF).reshape(B, H, MOBA_Q_CHUNK, n_sel)
        k_own = lax.dynamic_index_in_dim(k_blocks, own, axis=2, keepdims=False)
        v_own = lax.dynamic_index_in_dim(v_blocks, own, axis=2, keepdims=False)
        s_own = jnp.einsum('bhqd,bhkd->bhqk', qc, k_own).astype(jnp.float32) * scale
        kpos = own * MOBA_BLOCK + offs
        s_own = jnp.where(kpos[None, :] <= qpos[:, None], s_own, NEG_INF)
        p = jax.nn.softmax(jnp.concatenate([s_sel, s_own], axis=-1), axis=-1).astype(v.dtype)
        p_sel = p[..., :n_sel].reshape(B, H, MOBA_Q_CHUNK, MOBA_TOPK, MOBA_BLOCK)
        p_own = p[..., n_sel:]
        return (jnp.einsum('bhqnk,bhqnkd->bhqd', p_sel, v_sel)
                + jnp.einsum('bhqk,bhkd->bhqd', p_own, v_own))

    out = lax.map(attend_chunk, jnp.arange(S // MOBA_Q_CHUNK))
    out = out.transpose(1, 0, 3, 2, 4).reshape(B, S, H * Dh)
    return out @ w_o


def swiglu(x, w_in, w_out):
    g, u = jnp.split(x @ w_in, 2, axis=-1)
    return (jax.nn.silu(g) * u) @ w_out


def setup_inputs(seed: int = 0) -> dict:
    key = jax.random.key(seed)
    ks = jax.random.split(key, 20)
    nrm = lambda k, shape, fan_in, gain=1.0: jax.random.normal(k, shape, jnp.float32) * (fan_in ** -0.5) * gain
    gain_vec = lambda k, shape: 1.0 + 0.02 * jax.random.normal(k, shape, jnp.float32)
    Lm, Lb, L = N_MLA_LAYERS, N_MOBA_LAYERS, DEPTH
    return {
        "x": jax.random.normal(ks[0], (BATCH, SEQ, D_MODEL), jnp.float32),
        "mla_w_dqkv": nrm(ks[1], (Lm, D_MODEL, MLA_Q_RANK + MLA_KV_RANK + MLA_ROPE_DIM), D_MODEL),
        "mla_q_norm": gain_vec(ks[2], (Lm, MLA_Q_RANK)),
        "mla_w_uq": nrm(ks[3], (Lm, MLA_Q_RANK, MLA_HEADS * MLA_QK_DIM), MLA_Q_RANK),
        "mla_kv_norm": gain_vec(ks[4], (Lm, MLA_KV_RANK)),
        "mla_w_ukv": nrm(ks[5], (Lm, MLA_KV_RANK, MLA_HEADS * (MLA_NOPE_DIM + MLA_V_DIM)), MLA_KV_RANK),
        "mla_w_o": nrm(ks[6], (Lm, MLA_HEADS * MLA_V_DIM, D_MODEL), MLA_HEADS * MLA_V_DIM, DEEPNORM_BETA),
        "moba_w_qkv": nrm(ks[7], (Lb, D_MODEL, 3 * MOBA_HEADS * MOBA_HEAD_DIM), D_MODEL),
        "moba_w_o": nrm(ks[8], (Lb, MOBA_HEADS * MOBA_HEAD_DIM, D_MODEL), MOBA_HEADS * MOBA_HEAD_DIM, DEEPNORM_BETA),
        "ffn_w_in": nrm(ks[9], (L, D_MODEL, 2 * D_FF), D_MODEL),
        "ffn_w_out": nrm(ks[10], (L, D_FF, D_MODEL), D_FF, DEEPNORM_BETA),
        "ln_mix_g": gain_vec(ks[11], (L, D_MODEL)),
        "ln_mix_b": 0.02 * jax.random.normal(ks[12], (L, D_MODEL), jnp.float32),
        "ln_ffn_g": gain_vec(ks[13], (L, D_MODEL)),
        "ln_ffn_b": 0.02 * jax.random.normal(ks[14], (L, D_MODEL), jnp.float32),
    }


def reference(x, mla_w_dqkv, mla_q_norm, mla_w_uq, mla_kv_norm, mla_w_ukv, mla_w_o,
              moba_w_qkv, moba_w_o, ffn_w_in, ffn_w_out, ln_mix_g, ln_mix_b, ln_ffn_g, ln_ffn_b):
    S = x.shape[1]
    cos_mla, sin_mla = rotary_tables(S, MLA_ROPE_DIM)
    cos_moba, sin_moba = rotary_tables(S, MOBA_ROT_DIM)
    for i in range(DEPTH):
        j = i // N_MIXERS
        if i % N_MIXERS == 0:
            h = mla_mixer(x, cos_mla, sin_mla, mla_w_dqkv[j], mla_q_norm[j], mla_w_uq[j],
                          mla_kv_norm[j], mla_w_ukv[j], mla_w_o[j])
        else:
            h = moba_mixer(x, cos_moba, sin_moba, moba_w_qkv[j], moba_w_o[j])
        x = layer_norm(DEEPNORM_ALPHA * x + h, ln_mix_g[i], ln_mix_b[i])
        x = layer_norm(DEEPNORM_ALPHA * x + swiglu(x, ffn_w_in[i], ffn_w_out[i]), ln_ffn_g[i], ln_ffn_b[i])
    return x
```

```cpp
#include <hip/hip_runtime.h>
#include <hip/hip_cooperative_groups.h>
#include <cstdint>
#include <cstdio>
namespace cg = cooperative_groups;

#ifndef MK_MULTI
#define MK_MULTI 0
#endif
#define PROBE_MASK 0u

#define DI __device__ __forceinline__
typedef unsigned short bf16_t;
typedef short bf16x8 __attribute__((ext_vector_type(8)));
typedef short s16x4 __attribute__((ext_vector_type(4)));
typedef float f32x4 __attribute__((ext_vector_type(4)));
typedef float f32x16 __attribute__((ext_vector_type(16)));
typedef unsigned u32x4 __attribute__((ext_vector_type(4)));
typedef unsigned u32x2 __attribute__((ext_vector_type(2)));

constexpr int S = 16384, DM = 1024, DFF = 2816;
constexpr int NTHR = 512;
constexpr size_t MiB = 1u << 20;
constexpr size_t WS_CTL = 0;
constexpr size_t WS_COSM = 1 * MiB, WS_SINM = 3 * MiB;
constexpr size_t WS_COSB = 5 * MiB, WS_SINB = 6 * MiB;
constexpr size_t WS_KMH = 7 * MiB, WS_KML = 7 * MiB + 131072;
constexpr size_t WS_W1_QKV = 8 * MiB, WS_W1_O = 14 * MiB, WS_W1_IN = 16 * MiB, WS_W1_OUT = 27 * MiB;
constexpr size_t WS_W0_DQKV = 33 * MiB, WS_W0_UQ = 35 * MiB, WS_W0_UKV = 37 * MiB, WS_W0_O = 38 * MiB, WS_W0_IN = 40 * MiB, WS_W0_OUT = 51 * MiB;
constexpr size_t WS_XB = 57 * MiB;
constexpr size_t WS_R = 89 * MiB;
constexpr size_t WS_AO = WS_R, WS_LAT = WS_R + 32 * MiB, WS_KR = WS_R + 52 * MiB, WS_Q = WS_R + 54 * MiB, WS_KV = WS_R + 102 * MiB;
constexpr size_t WS_Y = WS_R + 102 * MiB;
constexpr size_t WS_H = WS_R;
constexpr size_t WS_ML = 33 * MiB;
constexpr size_t WS_LIST = 36 * MiB;
constexpr size_t WS_PART = 57 * MiB;
constexpr size_t WS_QKV = 153 * MiB;
constexpr size_t WS_Y1 = 89 * MiB;
constexpr size_t WS_END = 256 * MiB;
constexpr int CTL_CNT = 16384;

constexpr int LDS_BYTES = 131072 + 8192;
extern __shared__ __attribute__((aligned(16))) unsigned char g_lds[];

struct Params { const float* in[15]; float* out; unsigned char* ws; int ph_lo, ph_hi; };

DI unsigned cvtpk(float lo, float hi) { unsigned r; asm("v_cvt_pk_bf16_f32 %0, %1, %2" : "=v"(r) : "v"(lo), "v"(hi)); return r; }
DI float bf2f(unsigned short v) { return __uint_as_float((unsigned)v << 16); }
DI int crow(int r, int hi) { return (r & 3) + 8 * (r >> 2) + 4 * hi; }
DI float wave_sum(float v) {
#pragma unroll
    for (int o = 1; o < 64; o <<= 1) v += __shfl_xor(v, o);
    return v;
}

__device__ const double kInvFreq[32] = {1.0, 0.6636012376960885, 0.44036660267178046, 0.2922278225730151, 0.19392274474868576, 0.12868737343265052, 0.08539710028576561, 0.05666962144529105, 0.03760603093086393, 0.024955408670558694, 0.016560440080994446, 0.010989528534539826, 0.007292664737217109, 0.004839421345719893, 0.003211445994752591, 0.0021311195369119653, 0.001414213562373095, 0.0009384738703573802, 0.000622772421914596, 0.0004132725499855165, 0.0002742481756762073, 0.00018199142881462546, 0.00012076973741146504, 8.01429472224798e-05, 5.318295896944988e-05, 3.529227739646723e-05, 2.341999896140934e-05, 1.5541540297632344e-05, 1.031338537721246e-05, 6.8439753011549275e-06, 4.5416704806078695e-06, 3.013858152139171e-06};

DI int srcmap(int code, int n) {
    switch (code) {
        case 1: { if (n < 640) return n; if (n < 704) { int j = n - 640; return 640 + (j >> 1) + 32 * (j & 1); } return -1; }
        case 2: { int h = n / 192, c = n - h * 192; if (c < 128) return n; int j = c - 128; return h * 192 + 128 + (j >> 1) + 32 * (j & 1); }
        case 3: { if (n >= 2048) return n; int c = n & 127; if (c >= 32) return n; return (n & ~127) + (c >> 1) + 16 * (c & 1); }
        case 4: { int q = n >> 5, t = (n >> 4) & 1, i = n & 15; return t * DFF + 16 * q + i; }
        default: return n;
    }
}
DI void wtrans(const float* __restrict__ W, int K, int N, bf16_t* __restrict__ Wt, int Np, int code, const float* __restrict__ kscale) {
    float* tile = (float*)g_lds;
    const int tid = threadIdx.x;
    const int tk = K / 64, tn = Np / 64, nt = tk * tn;
    for (int t = blockIdx.x; t < nt; t += gridDim.x) {
        const int n0 = (t / tk) * 64, k0 = (t % tk) * 64;
        __syncthreads();
        {
            const int nn = tid & 63; const int src = srcmap(code, n0 + nn);
#pragma unroll
            for (int i = 0; i < 8; ++i) {
                const int kk = (tid >> 6) + 8 * i;
                float v = 0.f;
                if (src >= 0) { v = W[(size_t)(k0 + kk) * N + src]; if (kscale) v *= kscale[k0 + kk]; }
                tile[kk * 65 + nn] = v;
            }
        }
        __syncthreads();
        {
            const int kk = (tid & 31) * 2;
#pragma unroll
            for (int i = 0; i < 4; ++i) {
                const int nn = (tid >> 5) + 16 * i;
                *(unsigned*)(Wt + (size_t)(n0 + nn) * K + k0 + kk) = cvtpk(tile[kk * 65 + nn], tile[(kk + 1) * 65 + nn]);
            }
        }
    }
}

DI void prep_phase(const Params& P) {
    unsigned char* ws = P.ws;
    const int tid = threadIdx.x;
    const size_t gt = (size_t)blockIdx.x * NTHR + tid, gs = (size_t)gridDim.x * NTHR;
    {
        const float* x = P.in[0]; bf16_t* xb = (bf16_t*)(ws + WS_XB);
        for (size_t i = gt; i < (size_t)S * DM / 8; i += gs) {
            const f32x4 a = *(const f32x4*)(x + i * 8), b = *(const f32x4*)(x + i * 8 + 4);
            u32x4 w = {cvtpk(a[0], a[1]), cvtpk(a[2], a[3]), cvtpk(b[0], b[1]), cvtpk(b[2], b[3])};
            *(u32x4*)(xb + i * 8) = w;
        }
    }
    {
        float* cm = (float*)(ws + WS_COSM); float* sm = (float*)(ws + WS_SINM); float* cb = (float*)(ws + WS_COSB); float* sb = (float*)(ws + WS_SINB);
        for (size_t i = gt; i < (size_t)S * 32; i += gs) {
            const int pos = (int)(i >> 5), f = (int)(i & 31);
            const double rev = (double)pos * kInvFreq[f] * 0.15915494309189535;
            const float fr = (float)(rev - floor(rev));
            const float c = __builtin_amdgcn_cosf(fr), s = __builtin_amdgcn_sinf(fr);
            cm[i] = c; sm[i] = s;
            if ((f & 1) == 0) { cb[pos * 16 + (f >> 1)] = c; sb[pos * 16 + (f >> 1)] = s; }
        }
    }
    wtrans(P.in[1], 1024, 704, (bf16_t*)(ws + WS_W0_DQKV), 768, 1, nullptr);
    wtrans(P.in[3], 384, 1536, (bf16_t*)(ws + WS_W0_UQ), 1536, 2, P.in[2]);
    wtrans(P.in[5], 256, 2048, (bf16_t*)(ws + WS_W0_UKV), 2048, 0, P.in[4]);
    wtrans(P.in[6], 1024, 1024, (bf16_t*)(ws + WS_W0_O), 1024, 0, nullptr);
    wtrans(P.in[7], 1024, 3072, (bf16_t*)(ws + WS_W1_QKV), 3072, 3, nullptr);
    wtrans(P.in[8], 1024, 1024, (bf16_t*)(ws + WS_W1_O), 1024, 0, nullptr);
    wtrans(P.in[9], 1024, 2 * DFF, (bf16_t*)(ws + WS_W0_IN), 2 * DFF, 4, nullptr);
    wtrans(P.in[9] + (size_t)1024 * 2 * DFF, 1024, 2 * DFF, (bf16_t*)(ws + WS_W1_IN), 2 * DFF, 4, nullptr);
    wtrans(P.in[10], DFF, 1024, (bf16_t*)(ws + WS_W0_OUT), 1024, 0, nullptr);
    wtrans(P.in[10] + (size_t)DFF * 1024, DFF, 1024, (bf16_t*)(ws + WS_W1_OUT), 1024, 0, nullptr);
}

DI void ln_phase(const float* __restrict__ Y, const float* __restrict__ g, const float* __restrict__ b, float* __restrict__ XF, bf16_t* __restrict__ XBo) {
    const int tid = threadIdx.x, wave = tid >> 6, lane = tid & 63;
    for (int row = blockIdx.x * 8 + wave; row < S; row += gridDim.x * 8) {
        const f32x4* yr = (const f32x4*)(Y + (size_t)row * DM);
        f32x4 v[4];
#pragma unroll
        for (int i = 0; i < 4; ++i) v[i] = yr[lane + 64 * i];
        float s = 0.f;
#pragma unroll
        for (int i = 0; i < 4; ++i) s += (v[i][0] + v[i][1]) + (v[i][2] + v[i][3]);
        s = wave_sum(s);
        const float mean = s * (1.0f / DM);
        float q = 0.f;
#pragma unroll
        for (int i = 0; i < 4; ++i) { const f32x4 d = v[i] - mean; q += (d[0] * d[0] + d[1] * d[1]) + (d[2] * d[2] + d[3] * d[3]); }
        q = wave_sum(q);
        const float rstd = rsqrtf(q * (1.0f / DM) + 1e-5f);
#pragma unroll
        for (int i = 0; i < 4; ++i) {
            const int col = (lane + 64 * i) * 4;
            const f32x4 gg = *(const f32x4*)(g + col), bb = *(const f32x4*)(b + col);
            const f32x4 o = (v[i] - mean) * rstd * gg + bb;
            *(f32x4*)(XF + (size_t)row * DM + col) = o;
            if (XBo) { u32x2 w = {cvtpk(o[0], o[1]), cvtpk(o[2], o[3])}; *(u32x2*)(XBo + (size_t)row * DM + col) = w; }
        }
    }
}

constexpr int BM = 256, BK = 64, HALF = 128, HT = HALF * BK, NXCD = 8, WGM = 8;
DI int lds_byte(int r, int c) { int st = (r >> 4) * 2 + (c >> 5), rr = r & 15, cc = c & 31, ob = rr * 64 + cc * 2; return st * 1024 + (ob ^ (((ob >> 9) & 1) << 5)); }
DI void stage_rc(int b, int& R, int& C) { int st = b / 1024, sb = b % 1024, swz = sb ^ (((sb >> 9) & 1) << 5); R = (st >> 1) * 16 + swz / 64; C = (st & 1) * 32 + (swz % 64) / 2; }

#define LAS __attribute__((address_space(3)))
template <class Epi>
DI void gemm_tile(const bf16_t* __restrict__ A, int lda, const bf16_t* __restrict__ Bt, int K, int pm, int pn, const Epi& epi) {
    LAS unsigned char* lds = (LAS unsigned char*)g_lds;
    constexpr int HTB = HT * 2;
#define SA(b, h) (((b) * 2 + (h)) * HTB)
#define SB(b, h) ((4 + (b) * 2 + (h)) * HTB)
#define STAGE(bufoff, gbase, voff) do { _Pragma("unroll") for (int _i = 0; _i < 2; ++_i) \
        __builtin_amdgcn_global_load_lds((const unsigned*)((const char*)(gbase) + (voff)[_i]), (LAS unsigned*)(lds + (bufoff) + ldsw + _i * 8192), 16, 0, 0); } while (0)
#define LDA(dst, b, h) do { _Pragma("unroll") for (int m = 0; m < 4; ++m) _Pragma("unroll") for (int k = 0; k < 2; ++k) dst[m][k] = *(const LAS bf16x8*)(lds + SA(b, h) + aoff + m * 2048 + k * 1024); } while (0)
#define LDB(dst, b, h) do { _Pragma("unroll") for (int n = 0; n < 2; ++n) _Pragma("unroll") for (int k = 0; k < 2; ++k) dst[n][k] = *(const LAS bf16x8*)(lds + SB(b, h) + boff + n * 2048 + k * 1024); } while (0)
#define MMA(ai, bj, At_, Bt_) do { __builtin_amdgcn_s_setprio(1); \
    _Pragma("unroll") for (int m = 0; m < 4; ++m) _Pragma("unroll") for (int n = 0; n < 2; ++n) _Pragma("unroll") for (int k = 0; k < 2; ++k) \
      acc[ai][bj][m][n] = __builtin_amdgcn_mfma_f32_16x16x32_bf16(Bt_[n][k], At_[m][k], acc[ai][bj][m][n], 0, 0, 0); \
    __builtin_amdgcn_s_setprio(0); } while (0)
#define WAIT_V(n) asm volatile("s_waitcnt vmcnt(" #n ")" ::: "memory")
#define WAIT_L(n) asm volatile("s_waitcnt lgkmcnt(" #n ")" ::: "memory")
#define BAR __builtin_amdgcn_s_barrier()
#define SCHED __builtin_amdgcn_sched_barrier(0)
    __syncthreads();
    epi.pre(pm);
    int tid = threadIdx.x; asm volatile("" : "+v"(tid));
    const int wid = __builtin_amdgcn_readfirstlane(tid >> 6), lane = tid & 63, wr = wid >> 2, wc = wid & 3, fr = lane & 15, fq = lane >> 4;
    unsigned voffA[2], voffB[2];
#pragma unroll
    for (int i = 0; i < 2; ++i) { int R, C; stage_rc(tid * 16 + i * 8192, R, C); voffA[i] = (unsigned)(R * lda + C) * 2u; voffB[i] = (unsigned)(R * K + C) * 2u; }
    const size_t kstep = (size_t)(BK * 2), hA = (size_t)HALF * lda * 2, hB = (size_t)HALF * K * 2;
    const unsigned ldsw = (unsigned)wid * 1024u;
    const int aoff = lds_byte(wr * 64 + fr, fq * 8), boff = lds_byte(wc * 32 + fr, fq * 8);
    const char* cA = (const char*)A + (size_t)pm * 2 * hA; const char* cB = (const char*)Bt + (size_t)pn * 2 * hB;
    f32x4 acc[2][2][4][2];
#pragma unroll
    for (int a = 0; a < 2; ++a)
#pragma unroll
        for (int b = 0; b < 2; ++b)
#pragma unroll
            for (int m = 0; m < 4; ++m)
#pragma unroll
                for (int n = 0; n < 2; ++n) acc[a][b][m][n] = (f32x4){0.f, 0.f, 0.f, 0.f};
    bf16x8 At[4][2], B0[2][2], B1[2][2];
    const int nt = K / BK;
    STAGE(SB(0, 0), cB, voffB); STAGE(SA(0, 0), cA, voffA); STAGE(SB(0, 1), cB + hB, voffB); STAGE(SA(0, 1), cA + hA, voffA);
    if (wr == 1) BAR;
    WAIT_V(4); BAR;
    STAGE(SB(1, 0), cB + kstep, voffB); STAGE(SA(1, 0), cA + kstep, voffA); STAGE(SB(1, 1), cB + hB + kstep, voffB);
    WAIT_V(6); BAR;
    for (int t = 0; t < nt - 2; t += 2) {
        const char* a1 = cA + (size_t)(t + 1) * kstep;
        const char* a2 = cA + (size_t)(t + 2) * kstep; const char* b2 = cB + (size_t)(t + 2) * kstep;
        const char* a3 = a2 + kstep; const char* b3 = b2 + kstep;
        LDB(B0, 0, 0); SCHED; LDA(At, 0, 0); STAGE(SA(1, 1), a1 + hA, voffA);
        WAIT_L(8); BAR; WAIT_L(0); MMA(0, 0, At, B0); BAR; SCHED;
        LDB(B1, 0, 1); STAGE(SB(0, 0), b2, voffB);
        BAR; WAIT_L(0); MMA(0, 1, At, B1); BAR;
        LDA(At, 0, 1); STAGE(SA(0, 0), a2, voffA);
        BAR; WAIT_L(0); MMA(1, 0, At, B0); BAR; SCHED;
        STAGE(SB(0, 1), b2 + hB, voffB);
        WAIT_V(6); BAR; MMA(1, 1, At, B1); BAR;
        LDB(B0, 1, 0); SCHED; LDA(At, 1, 0); STAGE(SA(0, 1), a2 + hA, voffA);
        WAIT_L(8); BAR; WAIT_L(0); MMA(0, 0, At, B0); BAR; SCHED;
        LDB(B1, 1, 1); STAGE(SB(1, 0), b3, voffB);
        BAR; WAIT_L(0); MMA(0, 1, At, B1); BAR;
        LDA(At, 1, 1); STAGE(SA(1, 0), a3, voffA);
        BAR; WAIT_L(0); MMA(1, 0, At, B0); BAR; SCHED;
        STAGE(SB(1, 1), b3 + hB, voffB);
        WAIT_V(6); BAR; MMA(1, 1, At, B1); BAR;
    }
    { LDB(B0, 0, 0); LDA(At, 0, 0); STAGE(SA(1, 1), cA + (size_t)(nt - 1) * kstep + hA, voffA);
      BAR; WAIT_L(0); MMA(0, 0, At, B0); BAR;
      LDB(B1, 0, 1); BAR; WAIT_L(0); MMA(0, 1, At, B1); BAR;
      LDA(At, 0, 1); WAIT_V(4); BAR; WAIT_L(0); MMA(1, 0, At, B0); MMA(1, 1, At, B1); BAR; }
    { LDB(B0, 1, 0); LDA(At, 1, 0); WAIT_V(2); BAR; WAIT_L(0); MMA(0, 0, At, B0); BAR;
      LDB(B1, 1, 1); WAIT_V(0); BAR; WAIT_L(0); MMA(0, 1, At, B1); BAR;
      LDA(At, 1, 1); BAR; WAIT_L(0); MMA(1, 0, At, B0); MMA(1, 1, At, B1); BAR; }
    if (wr == 0) BAR;
    epi(acc, pm, pn, wr, wc, fr, fq);
#undef SA
#undef SB
#undef STAGE
#undef LDA
#undef LDB
#undef MMA
}

template <class Epi>
DI void gemm_phase(const bf16_t* A, int lda, const bf16_t* Bt, int K, int nM, int nN, const Epi& epi, int cshift = 0) {
    const int nwg = nM * nN, G = gridDim.x;
    const int c = ((int)blockIdx.x + cshift) % G;
    for (int i = 0;; ++i) {
        const long L = (long)i * G + c; if (L >= nwg) break;
        int wgid = (int)L;
        { const int q = nwg / NXCD, r = nwg % NXCD, xcd = wgid % NXCD, off = wgid / NXCD; wgid = (xcd < r ? xcd * (q + 1) : r * (q + 1) + (xcd - r) * q) + off; }
        const int nig = WGM * nN, gid = wgid / nig, fm = gid * WGM, gsz = (nM - fm) < WGM ? (nM - fm) : WGM;
        const int pm = fm + ((wgid % nig) % gsz), pn = (wgid % nig) / gsz;
        gemm_tile<Epi>(A, lda, Bt, K, pm, pn, epi);
    }
}

#define EPI_LOOP_BEGIN \
    _Pragma("unroll") for (int ai = 0; ai < 2; ++ai) _Pragma("unroll") for (int m = 0; m < 4; ++m) { \
        const int rl = ai * HALF + wr * 64 + m * 16 + fr; const int row = pm * BM + rl; (void)rl; \
        _Pragma("unroll") for (int bj = 0; bj < 2; ++bj) _Pragma("unroll") for (int n = 0; n < 2; ++n) { \
            const int col = pn * BM + bj * HALF + wc * 32 + n * 16 + fq * 4; f32x4 v = acc[ai][bj][m][n];
#define EPI_LOOP_END } }

DI void st_bf4(bf16_t* p, f32x4 v) { u32x2 w = {cvtpk(v[0], v[1]), cvtpk(v[2], v[3])}; *(u32x2*)p = w; }
DI f32x4 rope4(f32x4 v, const float* ct, const float* st) {
    const float c0 = ct[0], s0 = st[0], c1 = ct[1], s1 = st[1];
    return (f32x4){v[0] * c0 - v[1] * s0, v[1] * c0 + v[0] * s0, v[2] * c1 - v[3] * s1, v[3] * c1 + v[2] * s1};
}

struct EpiLat {
    bf16_t* LAT; bf16_t* KR; const float* cosM; const float* sinM;
    DI void pre(int) const {}
    DI void operator()(const f32x4 (&acc)[2][2][4][2], int pm, int pn, int wr, int wc, int fr, int fq) const {
        EPI_LOOP_BEGIN
            if (col < 640) st_bf4(LAT + (size_t)row * 640 + col, v);
            else if (col < 704) { const int i0 = (col - 640) >> 1; st_bf4(KR + (size_t)row * 64 + (col - 640), rope4(v, cosM + row * 32 + i0, sinM + row * 32 + i0)); }
        EPI_LOOP_END
    }
};
constexpr float QSCALE_A = 0.10411754627697264f;
constexpr float QSCALE_B = 0.12751743082459868f;
template <int KK> DI void rs_pre(const bf16_t* A, int lda, int pm) {
    float* rs = (float*)(g_lds + 131072);
    int tid = threadIdx.x; asm volatile("" : "+v"(tid));
    const int row = tid >> 1, half = tid & 1;
    const bf16_t* p = A + (size_t)(pm * BM + row) * lda + half * (KK / 2);
    float ss = 0.f;
#pragma unroll 4
    for (int i = 0; i < KK / 16; ++i) {
        const bf16x8 v = *(const bf16x8*)(p + i * 8);
#pragma unroll
        for (int j = 0; j < 8; ++j) { const float f = bf2f((unsigned short)v[j]); ss += f * f; }
    }
    ss += __shfl_xor(ss, 1);
    if (!half) rs[row] = rsqrtf(ss * (1.0f / KK) + 1e-6f);
}
struct EpiQ {
    const bf16_t* A; bf16_t* Q; const float* cosM; const float* sinM;
    DI void pre(int pm) const { rs_pre<384>(A, 640, pm); }
    DI void operator()(const f32x4 (&acc)[2][2][4][2], int pm, int pn, int wr, int wc, int fr, int fq) const {
        const float* rs = (const float*)(g_lds + 131072);
        EPI_LOOP_BEGIN
            v = v * (rs[rl] * QSCALE_A);
            const int c = col % 192;
            if (c >= 128) { const int i0 = (c - 128) >> 1; v = rope4(v, cosM + row * 32 + i0, sinM + row * 32 + i0); }
            st_bf4(Q + (size_t)row * 1536 + col, v);
        EPI_LOOP_END
    }
};
struct EpiKV {
    const bf16_t* A; bf16_t* KV;
    DI void pre(int pm) const { rs_pre<256>(A, 640, pm); }
    DI void operator()(const f32x4 (&acc)[2][2][4][2], int pm, int pn, int wr, int wc, int fr, int fq) const {
        const float* rs = (const float*)(g_lds + 131072);
        EPI_LOOP_BEGIN
            v = v * rs[rl];
            st_bf4(KV + (size_t)row * 2048 + col, v);
        EPI_LOOP_END
    }
};
struct EpiRes {
    const float* R; float* Y;
    DI void pre(int) const {}
    DI void operator()(const f32x4 (&acc)[2][2][4][2], int pm, int pn, int wr, int wc, int fr, int fq) const {
        EPI_LOOP_BEGIN
            const f32x4 r = *(const f32x4*)(R + (size_t)row * DM + col);
            *(f32x4*)(Y + (size_t)row * DM + col) = r * 1.4142135623730951f + v;
        EPI_LOOP_END
    }
};
struct EpiSwiglu {
    bf16_t* H;
    DI void pre(int) const {}
    DI void operator()(const f32x4 (&acc)[2][2][4][2], int pm, int pn, int wr, int wc, int fr, int fq) const {
#pragma unroll
        for (int ai = 0; ai < 2; ++ai)
#pragma unroll
            for (int m = 0; m < 4; ++m) {
                const int row = pm * BM + ai * HALF + wr * 64 + m * 16 + fr;
#pragma unroll
                for (int bj = 0; bj < 2; ++bj) {
                    const f32x4 g = acc[ai][bj][m][0], u = acc[ai][bj][m][1];
                    f32x4 h;
#pragma unroll
                    for (int j = 0; j < 4; ++j) h[j] = g[j] * __builtin_amdgcn_rcpf(1.0f + __builtin_amdgcn_exp2f(-1.4426950408889634f * g[j])) * u[j];
                    st_bf4(H + (size_t)row * DFF + pn * 128 + bj * 64 + wc * 16 + fq * 4, h);
                }
            }
    }
};
struct EpiMobaQKV {
    bf16_t* QKV; const float* cosB; const float* sinB;
    DI void pre(int) const {}
    DI void operator()(const f32x4 (&acc)[2][2][4][2], int pm, int pn, int wr, int wc, int fr, int fq) const {
        EPI_LOOP_BEGIN
            if (col < 2048) { const int c = col & 127; if (c < 32) { const int i0 = c >> 1; v = rope4(v, cosB + row * 16 + i0, sinB + row * 16 + i0); } }
            if (col < 1024) v = v * QSCALE_B;
            st_bf4(QKV + (size_t)row * 3072 + col, v);
        EPI_LOOP_END
    }
};

constexpr int AL_K0 = 0, AL_KB = 24576, AL_V0 = 49152, AL_VB = 16384, AL_W = 98304;
#define MFMA32(a, b, c) __builtin_amdgcn_mfma_f32_32x32x16_bf16((a), (b), (c), 0, 0, 0)
DI void dma16(const void* g, unsigned ldsoff) {
    __builtin_amdgcn_global_load_lds((const unsigned*)g, (LAS unsigned*)((LAS unsigned char*)g_lds + ldsoff), 16, 0, 0);
}
DI bf16x8 pack8(const f32x16& x, int s) {
    u32x4 w = {cvtpk(x[8 * s], x[8 * s + 1]), cvtpk(x[8 * s + 2], x[8 * s + 3]), cvtpk(x[8 * s + 4], x[8 * s + 5]), cvtpk(x[8 * s + 6], x[8 * s + 7])};
    return __builtin_bit_cast(bf16x8, w);
}
template <int ND> struct KBase { int b[ND == 12 ? 4 : 8]; };
template <int ND> DI KBase<ND> make_kbase(int r32, int hi) {
    KBase<ND> k;
    if constexpr (ND == 12) {
#pragma unroll
        for (int dd = 0; dd < 4; ++dd) k.b[dd] = r32 * 384 + (((dd * 2 + hi) ^ ((r32 >> 1) & 7)) << 4);
    } else {
#pragma unroll
        for (int dd = 0; dd < 8; ++dd) k.b[dd] = r32 * 256 + (((dd * 2 + hi) ^ (r32 & 15)) << 4);
    }
    return k;
}
DI unsigned v_lane_base(int lane) {
    const int i16 = lane & 15, g = lane >> 4, rowq = i16 >> 2, pp = i16 & 3, colblk = g & 1, hi = g >> 1;
    return (unsigned)(hi * 1024 + rowq * 64 + colblk * 32 + pp * 8);
}
template <int ND>
DI void qk_tile(int kbuf_off, const KBase<ND>& kb, const bf16x8* qr, f32x16& p0, f32x16& p1) {
    p0 = f32x16{}; p1 = f32x16{};
    constexpr int RS = (ND == 12) ? 384 : 256;
    const unsigned char* kbuf = g_lds + kbuf_off;
#pragma unroll
    for (int dg = 0; dg < ND / 2; ++dg) {
        bf16x8 b0[2], b1[2];
#pragma unroll
        for (int i = 0; i < 2; ++i) {
            const int d0 = dg * 2 + i;
            const unsigned char* a = (ND == 12) ? (kbuf + kb.b[d0 & 3] + (d0 >> 2) * 128) : (kbuf + kb.b[d0 & 7]);
            b0[i] = *(const bf16x8*)a; b1[i] = *(const bf16x8*)(a + 32 * RS);
        }
#pragma unroll
        for (int i = 0; i < 2; ++i) { p0 = MFMA32(b0[i], qr[dg * 2 + i], p0); p1 = MFMA32(b1[i], qr[dg * 2 + i], p1); }
        __builtin_amdgcn_sched_barrier(0);
    }
}
DI void sm_tile(f32x16& p0, f32x16& p1, f32x16 (&o)[4], float& m, float& l, bool domask, int qrel, float* alw, int r32, int hi, bf16x8& pa0, bf16x8& pa1, bf16x8& pa2, bf16x8& pa3) {
    if (domask) {
        const float NEG = -__builtin_inff();
#pragma unroll
        for (int r = 0; r < 16; ++r) { const int k0 = (r & 3) + 8 * (r >> 2) + 4 * hi; if (k0 > qrel) p0[r] = NEG; if (k0 + 32 > qrel) p1[r] = NEG; }
    }
    float mx = p0[0];
#pragma unroll
    for (int r = 1; r < 16; ++r) mx = fmaxf(mx, p0[r]);
#pragma unroll
    for (int r = 0; r < 16; ++r) mx = fmaxf(mx, p1[r]);
    { auto rr = __builtin_amdgcn_permlane32_swap(__float_as_uint(mx), __float_as_uint(mx), false, false);
      mx = fmaxf(__uint_as_float(rr[0]), __uint_as_float(rr[1])); }
    if (!__all(mx - m <= 11.0f)) {
        const float mn = fmaxf(m, mx);
        const float alpha = __builtin_amdgcn_exp2f(m - mn);
        m = mn; l *= alpha;
        if (hi == 0) alw[r32] = alpha;
        asm volatile("s_waitcnt lgkmcnt(0)" ::: "memory");
#pragma unroll
        for (int r = 0; r < 16; ++r) { const float a = alw[crow(r, hi)];
#pragma unroll
            for (int d0 = 0; d0 < 4; ++d0) o[d0][r] *= a; }
        asm volatile("s_waitcnt lgkmcnt(0)" ::: "memory");
    }
    float ps = 0.f;
#pragma unroll
    for (int r = 0; r < 16; ++r) { p0[r] = __builtin_amdgcn_exp2f(p0[r] - m); ps += p0[r]; }
#pragma unroll
    for (int r = 0; r < 16; ++r) { p1[r] = __builtin_amdgcn_exp2f(p1[r] - m); ps += p1[r]; }
    l += ps;
    pa0 = pack8(p0, 0); pa1 = pack8(p0, 1); pa2 = pack8(p1, 0); pa3 = pack8(p1, 1);
}
DI void pv_tile(unsigned vb, const bf16x8& pa0, const bf16x8& pa1, const bf16x8& pa2, const bf16x8& pa3, f32x16 (&o)[4]) {
#define TRRD(dst, off) asm volatile("ds_read_b64_tr_b16 %0, %1 offset:%2" : "=&v"(dst) : "v"(vb), "i"(off) : "memory")
#define PV_D0(d0) do { s16x4 l0, l1, h0, h1; constexpr int b_ = (d0) * 256; \
        TRRD(l0, b_); TRRD(h0, b_ + 2048); TRRD(l1, b_ + 4096); TRRD(h1, b_ + 6144); \
        asm volatile("s_waitcnt lgkmcnt(0)" ::: "memory"); __builtin_amdgcn_sched_barrier(0); \
        o[d0] = MFMA32(pa0, ((bf16x8){l0[0], l0[1], l0[2], l0[3], h0[0], h0[1], h0[2], h0[3]}), o[d0]); \
        o[d0] = MFMA32(pa1, ((bf16x8){l1[0], l1[1], l1[2], l1[3], h1[0], h1[1], h1[2], h1[3]}), o[d0]); \
        TRRD(l0, b_ + 8192); TRRD(h0, b_ + 10240); TRRD(l1, b_ + 12288); TRRD(h1, b_ + 14336); \
        asm volatile("s_waitcnt lgkmcnt(0)" ::: "memory"); __builtin_amdgcn_sched_barrier(0); \
        o[d0] = MFMA32(pa2, ((bf16x8){l0[0], l0[1], l0[2], l0[3], h0[0], h0[1], h0[2], h0[3]}), o[d0]); \
        o[d0] = MFMA32(pa3, ((bf16x8){l1[0], l1[1], l1[2], l1[3], h1[0], h1[1], h1[2], h1[3]}), o[d0]); } while (0)
    PV_D0(0); PV_D0(1); PV_D0(2); PV_D0(3);
#undef PV_D0
#undef TRRD
}
template <int ND>
DI void attn_tile(int kbuf_off, unsigned vb, const KBase<ND>& kb, const bf16x8* qr, f32x16 (&o)[4], float& m, float& l, bool domask, int qrel, float* alw, int r32, int hi) {
    f32x16 p0, p1; bf16x8 pa0, pa1, pa2, pa3;
    qk_tile<ND>(kbuf_off, kb, qr, p0, p1);
    sm_tile(p0, p1, o, m, l, domask, qrel, alw, r32, hi, pa0, pa1, pa2, pa3);
    pv_tile(vb, pa0, pa1, pa2, pa3, o);
}
#define VM_DRAIN() asm volatile("s_waitcnt vmcnt(0)" ::: "memory")

DI void mla_block(const bf16_t* __restrict__ Q, const bf16_t* __restrict__ KV, const bf16_t* __restrict__ KR, bf16_t* __restrict__ AO, int h, int qb) {
    int tid = threadIdx.x; asm volatile("" : "+v"(tid));
    const int w = __builtin_amdgcn_readfirstlane(tid >> 6), lane = tid & 63, r32 = lane & 31, hi = lane >> 5;
    float* alw = (float*)(g_lds + AL_W + w * 512);
    const int NT = 4 * qb + 4, tmax = 4 * qb + (w >> 1);
    const int row = qb * 256 + w * 32 + r32;
    bf16x8 qr[12];
    { const bf16_t* qp = Q + (size_t)row * 1536 + h * 192 + hi * 8;
#pragma unroll
      for (int d0 = 0; d0 < 12; ++d0) qr[d0] = *(const bf16x8*)(qp + d0 * 16); }
    int ksrc[3], vsrc[2];
#pragma unroll
    for (int i = 0; i < 3; ++i) { const int b = (i * 8 + w) * 1024 + lane * 16, kr = b / 384, pc = (b - kr * 384) >> 4, c = pc ^ ((kr >> 1) & 7);
        ksrc[i] = (c < 16) ? (kr * 2048 + h * 256 + c * 8) : -(kr * 64 + (c - 16) * 8) - 1; }
#pragma unroll
    for (int i = 0; i < 2; ++i) { const int key = (i * 8 + w) * 4 + ((lane >> 2) & 3), col = (lane >> 4) * 32 + (lane & 3) * 8; vsrc[i] = key * 2048 + h * 256 + 128 + col; }
#define MLA_ISSUE(t_, kb_, vb_) do { const bf16_t* kvb_ = KV + (size_t)(t_) * 64 * 2048; const bf16_t* krb_ = KR + (size_t)(t_) * 64 * 64; \
    _Pragma("unroll") for (int i = 0; i < 3; ++i) dma16((ksrc[i] >= 0) ? (const void*)(kvb_ + ksrc[i]) : (const void*)(krb_ + (-ksrc[i] - 1)), AL_K0 + (kb_) * AL_KB + (i * 8 + w) * 1024); \
    _Pragma("unroll") for (int i = 0; i < 2; ++i) dma16(kvb_ + vsrc[i], AL_V0 + (vb_) * AL_VB + (i * 8 + w) * 1024); } while (0)
    f32x16 o[4] = {};
    float m = -1e30f, l = 0.f;
    const unsigned vb0 = (unsigned)(uintptr_t)(g_lds + AL_V0) + v_lane_base(lane);
    const KBase<12> kb = make_kbase<12>(r32, hi);
    MLA_ISSUE(0, 0, 0); VM_DRAIN();
    __syncthreads();
    f32x16 p0, p1; bf16x8 pa0, pa1, pa2, pa3;
    int vb3 = 0;
    if (w < 4) {
#pragma unroll 1
        for (int t = 0; t < NT; ++t) {
            const int vn = (vb3 == 2) ? 0 : vb3 + 1;
            if (t + 1 < NT) MLA_ISSUE(t + 1, (t + 1) & 1, vn);
            if (t <= tmax) {
                qk_tile<12>(AL_K0 + (t & 1) * AL_KB, kb, qr, p0, p1);
                sm_tile(p0, p1, o, m, l, t == tmax, row - t * 64, alw, r32, hi, pa0, pa1, pa2, pa3);
                pv_tile(vb0 + vb3 * AL_VB, pa0, pa1, pa2, pa3, o);
            }
            vb3 = vn;
            VM_DRAIN();
            __syncthreads();
        }
    } else {
        int vprev = 0;
#pragma unroll 1
        for (int t = 0; t < NT; ++t) {
            const int vn = (vb3 == 2) ? 0 : vb3 + 1;
            if (t + 1 < NT) MLA_ISSUE(t + 1, (t + 1) & 1, vn);
            if (t >= 1 && t - 1 <= tmax) {
                sm_tile(p0, p1, o, m, l, t - 1 == tmax, row - (t - 1) * 64, alw, r32, hi, pa0, pa1, pa2, pa3);
                pv_tile(vb0 + vprev * AL_VB, pa0, pa1, pa2, pa3, o);
            }
            if (t <= tmax) qk_tile<12>(AL_K0 + (t & 1) * AL_KB, kb, qr, p0, p1);
            vprev = vb3; vb3 = vn;
            VM_DRAIN();
            __syncthreads();
        }
        if (NT - 1 <= tmax) {
            sm_tile(p0, p1, o, m, l, NT - 1 == tmax, row - (NT - 1) * 64, alw, r32, hi, pa0, pa1, pa2, pa3);
            pv_tile(vb0 + vprev * AL_VB, pa0, pa1, pa2, pa3, o);
        }
    }
#undef MLA_ISSUE
    const float lt = l + __shfl_xor(l, 32);
    if (hi == 0) alw[r32] = __builtin_amdgcn_rcpf(lt);
    asm volatile("s_waitcnt lgkmcnt(0)" ::: "memory");
    bf16_t* Ow = AO + (size_t)(qb * 256 + w * 32) * 1024 + h * 128;
#pragma unroll
    for (int r = 0; r < 16; ++r) { const int orow = crow(r, hi); const float inv = alw[orow];
#pragma unroll
        for (int d0 = 0; d0 < 4; ++d0) { const float v = o[d0][r] * inv; const float vn = __shfl_xor(v, 1);
            if ((r32 & 1) == 0) *(unsigned*)(Ow + (size_t)orow * 1024 + d0 * 32 + r32) = cvtpk(v, vn); } }
    asm volatile("s_waitcnt lgkmcnt(0)" ::: "memory");
}
DI void mla_attn_phase(const Params& P) {
    const bf16_t* Q = (const bf16_t*)(P.ws + WS_Q); const bf16_t* KV = (const bf16_t*)(P.ws + WS_KV); const bf16_t* KR = (const bf16_t*)(P.ws + WS_KR);
    bf16_t* AO = (bf16_t*)(P.ws + WS_AO);
    for (int item = blockIdx.x; item < 256; item += gridDim.x) {
        const int h = item & 7, p = item >> 3;
#pragma unroll 1
        for (int sub = 0; sub < 2; ++sub) mla_block(Q, KV, KR, AO, h, sub ? p : 63 - p);
    }
}

DI void moba_kmean_phase(const Params& P) {
    const bf16_t* QKV = (const bf16_t*)(P.ws + WS_QKV); bf16_t* KMH = (bf16_t*)(P.ws + WS_KMH); bf16_t* KML = (bf16_t*)(P.ws + WS_KML);
    float* red = (float*)g_lds;
    const int tid = threadIdx.x, d = tid & 127, part = tid >> 7;
    for (int item = blockIdx.x; item < 512; item += gridDim.x) {
        const int h = item >> 6, j = item & 63;
        const bf16_t* kp = QKV + (size_t)(j * 256 + part * 64) * 3072 + 1024 + h * 128 + d;
        float s = 0.f;
        for (int i = 0; i < 64; ++i) s += bf2f(kp[(size_t)i * 3072]);
        __syncthreads();
        red[tid] = s;
        __syncthreads();
        if (tid < 128) {
            const float km = ((red[tid] + red[tid + 128]) + (red[tid + 256] + red[tid + 384])) * (1.0f / 256.0f);
            const unsigned hb = cvtpk(km, 0.f) & 0xffffu; const float hf = bf2f((unsigned short)hb);
            const unsigned lb = cvtpk(km - hf, 0.f) & 0xffffu;
            KMH[item * 128 + tid] = (bf16_t)hb; KML[item * 128 + tid] = (bf16_t)lb;
        }
    }
}
#define TOP3_INS(v_, i_) do { const float vv_ = (v_); const int ii_ = (i_); \
    if (vv_ > v1 || (vv_ == v1 && ii_ < i1)) { v3 = v2; i3 = i2; v2 = v1; i2 = i1; v1 = vv_; i1 = ii_; } \
    else if (vv_ > v2 || (vv_ == v2 && ii_ < i2)) { v3 = v2; i3 = i2; v2 = vv_; i2 = ii_; } \
    else if (vv_ > v3 || (vv_ == v3 && ii_ < i3)) { v3 = vv_; i3 = ii_; } } while (0)
DI void moba_gate_phase(const Params& P) {
    const bf16_t* QKV = (const bf16_t*)(P.ws + WS_QKV); const bf16_t* KMH = (const bf16_t*)(P.ws + WS_KMH); const bf16_t* KML = (const bf16_t*)(P.ws + WS_KML);
    unsigned* cnt = (unsigned*)(P.ws + WS_CTL) + CTL_CNT; unsigned short* list = (unsigned short*)(P.ws + WS_LIST); float2* ML = (float2*)(P.ws + WS_ML);
    const int tid = threadIdx.x, w = tid >> 6, lane = tid & 63, r32 = lane & 31, hi = lane >> 5;
    unsigned* lcnt = (unsigned*)g_lds; unsigned* lbase = lcnt + 64;
    for (int item = blockIdx.x; item < 512; item += gridDim.x) {
        const int h = item & 7, tq = item >> 3;
        const int q = tq * 256 + w * 32 + r32;
        float v1 = -3e38f, v2 = -3e38f, v3 = -3e38f; int i1 = 255, i2 = 255, i3 = 255;
        if (tq > 0) {
            bf16x8 qr[8];
            { const bf16_t* qp = QKV + (size_t)q * 3072 + h * 128 + hi * 8;
#pragma unroll
              for (int d0 = 0; d0 < 8; ++d0) qr[d0] = *(const bf16x8*)(qp + d0 * 16); }
#pragma unroll
            for (int u = 0; u < 2; ++u) {
                if (32 * u < tq) {
                    f32x16 g = {};
                    const size_t ko = (size_t)((h * 64 + 32 * u + r32) * 128 + hi * 8);
#pragma unroll
                    for (int d0 = 0; d0 < 8; ++d0) {
                        g = MFMA32(*(const bf16x8*)(KMH + ko + d0 * 16), qr[d0], g);
                        g = MFMA32(*(const bf16x8*)(KML + ko + d0 * 16), qr[d0], g);
                    }
#pragma unroll
                    for (int r = 0; r < 16; ++r) { const int blk = 32 * u + crow(r, hi); if (blk < tq) TOP3_INS(g[r], blk); }
                }
            }
            const float pv1 = __shfl_xor(v1, 32), pv2 = __shfl_xor(v2, 32), pv3 = __shfl_xor(v3, 32);
            const int pi1 = __shfl_xor(i1, 32), pi2 = __shfl_xor(i2, 32), pi3 = __shfl_xor(i3, 32);
            if (pi1 < 255) TOP3_INS(pv1, pi1);
            if (pi2 < 255) TOP3_INS(pv2, pi2);
            if (pi3 < 255) TOP3_INS(pv3, pi3);
        }
        __syncthreads();
        if (tid < 64) { lcnt[tid] = 0u; }
        __syncthreads();
        const int sel[3] = {i1, i2, i3};
        unsigned lpos[3] = {0u, 0u, 0u};
        if (hi == 0) {
#pragma unroll
            for (int s = 0; s < 3; ++s) {
                if (sel[s] < 255) lpos[s] = atomicAdd(&lcnt[sel[s]], 1u);
                else ML[(size_t)(q * 8 + h) * 3 + s] = make_float2(-1e30f, 0.f);
            }
        }
        __syncthreads();
        if (tid < 64) { const unsigned c = lcnt[tid]; lbase[tid] = c ? atomicAdd(&cnt[h * 64 + tid], c) : 0u; }
        __syncthreads();
        if (hi == 0) {
#pragma unroll
            for (int s = 0; s < 3; ++s)
                if (sel[s] < 255) list[(size_t)(h * 64 + sel[s]) * 16384 + lbase[sel[s]] + lpos[s]] = (unsigned short)((q << 2) | s);
        }
    }
}
#define MB_DECL int mb_k[2], mb_v[2]; \
    _Pragma("unroll") for (int i = 0; i < 2; ++i) { const int kr_ = (i * 8 + w) * 4 + (lane >> 4), c_ = (lane & 15) ^ (kr_ & 15); mb_k[i] = kr_ * 3072 + 1024 + c_ * 8; \
        const int key_ = (i * 8 + w) * 4 + ((lane >> 2) & 3), col_ = (lane >> 4) * 32 + (lane & 3) * 8; mb_v[i] = key_ * 3072 + 2048 + col_; }
#define MB_ISSUE(key0_, b_) do { const bf16_t* g_ = QKV + (size_t)(key0_) * 3072 + h * 128; \
    _Pragma("unroll") for (int i = 0; i < 2; ++i) { dma16(g_ + mb_k[i], AL_K0 + (b_) * AL_KB + (i * 8 + w) * 1024); dma16(g_ + mb_v[i], AL_V0 + (b_) * AL_VB + (i * 8 + w) * 1024); } } while (0)

DI void moba_sel_phase(const Params& P) {
    const bf16_t* QKV = (const bf16_t*)(P.ws + WS_QKV);
    const unsigned* cnt = (const unsigned*)(P.ws + WS_CTL) + CTL_CNT; const unsigned short* list = (const unsigned short*)(P.ws + WS_LIST);
    float2* ML = (float2*)(P.ws + WS_ML); bf16_t* PART = (bf16_t*)(P.ws + WS_PART);
    const int tid = threadIdx.x, w = __builtin_amdgcn_readfirstlane(tid >> 6), lane = tid & 63, r32 = lane & 31, hi = lane >> 5;
    int* pre = (int*)(g_lds + 100 * 1024);
    float* alw = (float*)(g_lds + AL_W + w * 512);
    unsigned* cdw = (unsigned*)(alw + 32);
    __syncthreads();
    pre[tid + 1] = (int)((__hip_atomic_load(cnt + tid, __ATOMIC_RELAXED, __HIP_MEMORY_SCOPE_AGENT) + 255u) >> 8);
    __syncthreads();
    if (tid == 0) { int a = 0; pre[0] = 0; for (int i = 1; i <= 512; ++i) { a += pre[i]; pre[i] = a; } }
    __syncthreads();
    const int T = pre[512];
    const unsigned vb0 = (unsigned)(uintptr_t)(g_lds + AL_V0) + v_lane_base(lane);
    const KBase<8> kb = make_kbase<8>(r32, hi);
    MB_DECL;
    for (int cid = blockIdx.x; cid < T; cid += gridDim.x) {
        int lo = 0, hi_ = 512;
        while (hi_ - lo > 1) { const int mid = (lo + hi_) >> 1; if (pre[mid] <= cid) lo = mid; else hi_ = mid; }
        const int hj = lo, h = hj >> 6, j = hj & 63, c = cid - pre[hj];
        const int n = (int)__hip_atomic_load(cnt + hj, __ATOMIC_RELAXED, __HIP_MEMORY_SCOPE_AGENT);
        const int e0 = c * 256 + w * 32;
        const bool wact = e0 < n;
        const bool valid = (e0 + r32) < n;
        const unsigned code = list[(size_t)hj * 16384 + (valid ? (e0 + r32) : (wact ? e0 : 0))];
        const int q = (int)(code >> 2), slot = (int)(code & 3);
        bf16x8 qr[8];
        { const bf16_t* qp = QKV + (size_t)q * 3072 + h * 128 + hi * 8;
#pragma unroll
          for (int d0 = 0; d0 < 8; ++d0) qr[d0] = *(const bf16x8*)(qp + d0 * 16); }
        f32x16 o[4] = {};
        float m = -1e30f, l = 0.f;
        MB_ISSUE(j * 256, 0); VM_DRAIN();
        __syncthreads();
#pragma unroll 1
        for (int t = 0; t < 4; ++t) {
            const int b = t & 1;
            if (t + 1 < 4) MB_ISSUE(j * 256 + (t + 1) * 64, b ^ 1);
            if (wact) attn_tile<8>(AL_K0 + b * AL_KB, vb0 + b * AL_VB, kb, qr, o, m, l, false, 0, alw, r32, hi);
            VM_DRAIN();
            __syncthreads();
        }
        if (wact) {
            const float lt = l + __shfl_xor(l, 32);
            if (hi == 0) { alw[r32] = __builtin_amdgcn_rcpf(lt); cdw[r32] = valid ? code : 0xffffffffu; if (valid) ML[(size_t)(q * 8 + h) * 3 + slot] = make_float2(m, lt); }
            asm volatile("s_waitcnt lgkmcnt(0)" ::: "memory");
#pragma unroll
            for (int r = 0; r < 16; ++r) { const int orow = crow(r, hi); const float inv = alw[orow]; const unsigned cd = cdw[orow];
                bf16_t* dst = PART + ((size_t)((cd >> 2) * 3 + (cd & 3)) * 8 + h) * 128;
#pragma unroll
                for (int d0 = 0; d0 < 4; ++d0) { const float v = o[d0][r] * inv; const float vn = __shfl_xor(v, 1);
                    if ((r32 & 1) == 0 && cd != 0xffffffffu) *(unsigned*)(dst + d0 * 32 + r32) = cvtpk(v, vn); } }
            asm volatile("s_waitcnt lgkmcnt(0)" ::: "memory");
        }
    }
}
DI void moba_own_phase(const Params& P) {
    bf16_t* QKV = (bf16_t*)(P.ws + WS_QKV);
    const float2* ML = (const float2*)(P.ws + WS_ML); const bf16_t* PART = (const bf16_t*)(P.ws + WS_PART);
    const int tid = threadIdx.x, w = __builtin_amdgcn_readfirstlane(tid >> 6), lane = tid & 63, r32 = lane & 31, hi = lane >> 5;
    float* alw = (float*)(g_lds + AL_W + w * 512);
    const unsigned vb0 = (unsigned)(uintptr_t)(g_lds + AL_V0) + v_lane_base(lane);
    const KBase<8> kb = make_kbase<8>(r32, hi);
    MB_DECL;
    for (int item = blockIdx.x; item < 512; item += gridDim.x) {
        const int h = item & 7, tq = item >> 3;
        const int q = tq * 256 + w * 32 + r32;
        bf16x8 qr[8];
        { const bf16_t* qp = QKV + (size_t)q * 3072 + h * 128 + hi * 8;
#pragma unroll
          for (int d0 = 0; d0 < 8; ++d0) qr[d0] = *(const bf16x8*)(qp + d0 * 16); }
        f32x16 o[4] = {};
        float m = -1e30f, l = 0.f;
        const int tmax = w >> 1;
        MB_ISSUE(tq * 256, 0); VM_DRAIN();
        __syncthreads();
#pragma unroll 1
        for (int t = 0; t < 4; ++t) {
            const int b = t & 1;
            if (t + 1 < 4) MB_ISSUE(tq * 256 + (t + 1) * 64, b ^ 1);
            if (t <= tmax) attn_tile<8>(AL_K0 + b * AL_KB, vb0 + b * AL_VB, kb, qr, o, m, l, t == tmax, w * 32 + r32 - t * 64, alw, r32, hi);
            VM_DRAIN();
            __syncthreads();
        }
        const float lt = l + __shfl_xor(l, 32);
        const float2* mlp = ML + (size_t)(q * 8 + h) * 3;
        const float2 a0 = mlp[0], a1 = mlp[1], a2 = mlp[2];
        const float M = fmaxf(fmaxf(m, a0.x), fmaxf(a1.x, a2.x));
        const float wo = __builtin_amdgcn_exp2f(m - M);
        const float w0 = a0.y > 0.f ? a0.y * __builtin_amdgcn_exp2f(a0.x - M) : 0.f;
        const float w1 = a1.y > 0.f ? a1.y * __builtin_amdgcn_exp2f(a1.x - M) : 0.f;
        const float w2 = a2.y > 0.f ? a2.y * __builtin_amdgcn_exp2f(a2.x - M) : 0.f;
        const float inv = __builtin_amdgcn_rcpf(lt * wo + w0 + w1 + w2);
        if (hi == 0) { alw[r32] = wo * inv; alw[32 + r32] = w0 * inv; alw[64 + r32] = w1 * inv; alw[96 + r32] = w2 * inv; }
        asm volatile("s_waitcnt lgkmcnt(0)" ::: "memory");
        float* ob = (float*)g_lds + w * (32 * 68);
        const int rr = lane >> 1, cs = (lane & 1) * 32;
        const float c1 = alw[32 + rr], c2 = alw[64 + rr], c3 = alw[96 + rr];
        bf16_t* Ow = QKV + (size_t)(tq * 256 + w * 32 + rr) * 3072 + h * 128 + cs;
        const bf16_t* pp = PART + ((size_t)(tq * 256 + w * 32 + rr) * 24 + h) * 128 + cs;
#pragma unroll
        for (int half = 0; half < 2; ++half) {
#pragma unroll
            for (int r = 0; r < 16; ++r) { const int orow = crow(r, hi); const float c0 = alw[orow];
                ob[orow * 68 + r32] = o[2 * half][r] * c0; ob[orow * 68 + 32 + r32] = o[2 * half + 1][r] * c0; }
            asm volatile("s_waitcnt lgkmcnt(0)" ::: "memory");
            bf16x8 s0[4], s1[4], s2[4];
#pragma unroll
            for (int i = 0; i < 4; ++i) { s0[i] = *(const bf16x8*)(pp + half * 64 + i * 8); s1[i] = *(const bf16x8*)(pp + 1024 + half * 64 + i * 8); s2[i] = *(const bf16x8*)(pp + 2048 + half * 64 + i * 8); }
#pragma unroll
            for (int i = 0; i < 4; ++i) {
                const f32x4 a = *(const f32x4*)(ob + rr * 68 + cs + i * 8), bq = *(const f32x4*)(ob + rr * 68 + cs + i * 8 + 4);
                float v[8] = {a[0], a[1], a[2], a[3], bq[0], bq[1], bq[2], bq[3]};
#pragma unroll
                for (int j = 0; j < 8; ++j) {
                    v[j] += (c1 > 0.f) ? c1 * bf2f((unsigned short)s0[i][j]) : 0.f;
                    v[j] += (c2 > 0.f) ? c2 * bf2f((unsigned short)s1[i][j]) : 0.f;
                    v[j] += (c3 > 0.f) ? c3 * bf2f((unsigned short)s2[i][j]) : 0.f;
                }
                u32x4 wv = {cvtpk(v[0], v[1]), cvtpk(v[2], v[3]), cvtpk(v[4], v[5]), cvtpk(v[6], v[7])};
                *(u32x4*)(Ow + half * 64 + i * 8) = wv;
            }
            asm volatile("s_waitcnt lgkmcnt(0)" ::: "memory");
        }
        __syncthreads();
    }
}

constexpr int NPHASE = 19;
__global__ void __launch_bounds__(NTHR) fwd_megakernel(Params P) {
    unsigned char* ws = P.ws;
    const float* cosM = (const float*)(ws + WS_COSM); const float* sinM = (const float*)(ws + WS_SINM);
    const float* cosB = (const float*)(ws + WS_COSB); const float* sinB = (const float*)(ws + WS_SINB);
    bf16_t* XB = (bf16_t*)(ws + WS_XB);
    float* XF = P.out;
    const int lo = P.ph_lo, hi = P.ph_hi;
#define IN(k) (lo <= (k) && (k) < hi)
#define SEAM(k) do { if (IN(k) && IN((k) + 1)) cg::this_grid().sync(); } while (0)
    if (IN(0)) prep_phase(P);
    SEAM(0);
    if (IN(1)) { EpiLat e{(bf16_t*)(ws + WS_LAT), (bf16_t*)(ws + WS_KR), cosM, sinM};
        gemm_phase(XB, 1024, (const bf16_t*)(ws + WS_W0_DQKV), 1024, 64, 3, e); }
    SEAM(1);
    if (IN(2)) {
        { EpiQ e{(const bf16_t*)(ws + WS_LAT), (bf16_t*)(ws + WS_Q), cosM, sinM};
          gemm_phase((const bf16_t*)(ws + WS_LAT), 640, (const bf16_t*)(ws + WS_W0_UQ), 384, 64, 6, e); }
        { EpiKV e{(const bf16_t*)(ws + WS_LAT) + 384, (bf16_t*)(ws + WS_KV)};
          gemm_phase((const bf16_t*)(ws + WS_LAT) + 384, 640, (const bf16_t*)(ws + WS_W0_UKV), 256, 64, 8, e, 128); }
    }
    SEAM(2);
    if (IN(3)) mla_attn_phase(P);
    SEAM(3);
    if (IN(4)) { EpiRes e{P.in[0], (float*)(ws + WS_Y)};
        gemm_phase((const bf16_t*)(ws + WS_AO), 1024, (const bf16_t*)(ws + WS_W0_O), 1024, 64, 4, e); }
    SEAM(4);
    if (IN(5)) ln_phase((const float*)(ws + WS_Y), P.in[11], P.in[12], XF, XB);
    SEAM(5);
    if (IN(6)) { EpiSwiglu e{(bf16_t*)(ws + WS_H)};
        gemm_phase(XB, 1024, (const bf16_t*)(ws + WS_W0_IN), 1024, 64, 22, e); }
    SEAM(6);
    if (IN(7)) { EpiRes e{XF, (float*)(ws + WS_Y)};
        gemm_phase((const bf16_t*)(ws + WS_H), DFF, (const bf16_t*)(ws + WS_W0_OUT), DFF, 64, 4, e); }
    SEAM(7);
    if (IN(8)) ln_phase((const float*)(ws + WS_Y), P.in[13], P.in[14], XF, XB);
    SEAM(8);
    if (IN(9)) { EpiMobaQKV e{(bf16_t*)(ws + WS_QKV), cosB, sinB};
        gemm_phase(XB, 1024, (const bf16_t*)(ws + WS_W1_QKV), 1024, 64, 12, e); }
    SEAM(9);
    if (IN(10)) moba_kmean_phase(P);
    SEAM(10);
    if (IN(11)) moba_gate_phase(P);
    SEAM(11);
    if (IN(12)) moba_sel_phase(P);
    SEAM(12);
    if (IN(13)) moba_own_phase(P);
    SEAM(13);
    if (IN(14)) { EpiRes e{XF, (float*)(ws + WS_Y1)};
        gemm_phase((const bf16_t*)(ws + WS_QKV), 3072, (const bf16_t*)(ws + WS_W1_O), 1024, 64, 4, e); }
    SEAM(14);
    if (IN(15)) ln_phase((const float*)(ws + WS_Y1), P.in[11] + DM, P.in[12] + DM, XF, XB);
    SEAM(15);
    if (IN(16)) { EpiSwiglu e{(bf16_t*)(ws + WS_H)};
        gemm_phase(XB, 1024, (const bf16_t*)(ws + WS_W1_IN), 1024, 64, 22, e); }
    SEAM(16);
    if (IN(17)) { EpiRes e{XF, (float*)(ws + WS_Y)};
        gemm_phase((const bf16_t*)(ws + WS_H), DFF, (const bf16_t*)(ws + WS_W1_OUT), DFF, 64, 4, e); }
    SEAM(17);
    if (IN(18)) ln_phase((const float*)(ws + WS_Y), P.in[13] + DM, P.in[14] + DM, XF, nullptr);
#undef IN
#undef SEAM
}

extern "C" void kernel_launch(void* const* d_in, const int* in_sizes, int n_in, void* d_out, int out_size, void* d_ws, size_t ws_size, hipStream_t stream) {
    static int grid = 0;
    if (grid == 0) {
        if (n_in != 15 || out_size != S * DM || ws_size < WS_END) { fprintf(stderr, "kernel_launch: unexpected shapes (n_in %d out %d ws %zu)\n", n_in, out_size, ws_size); grid = -1; return; }
        int dev = 0, cus = 0, per_cu = 0;
        (void)hipGetDevice(&dev);
        (void)hipDeviceGetAttribute(&cus, hipDeviceAttributeMultiprocessorCount, dev);
        (void)hipFuncSetAttribute((const void*)fwd_megakernel, hipFuncAttributeMaxDynamicSharedMemorySize, LDS_BYTES);
        (void)hipOccupancyMaxActiveBlocksPerMultiprocessor(&per_cu, (const void*)fwd_megakernel, NTHR, LDS_BYTES);
        if (per_cu < 1) per_cu = 1;
        grid = cus * per_cu;
        if (grid <= 0) grid = 256;
    }
    if (grid < 0) return;
    (void)hipMemsetAsync((char*)d_ws + WS_CTL, 0, 1 * MiB, stream);
    Params p{};
    for (int i = 0; i < 15; ++i) p.in[i] = (const float*)d_in[i];
    p.out = (float*)d_out; p.ws = (unsigned char*)d_ws;
#if MK_MULTI
    for (int ph = 0; ph < NPHASE; ++ph) {
        p.ph_lo = ph; p.ph_hi = ph + 1;
        for (int rep = 0; rep < (((PROBE_MASK >> ph) & 1u) ? 2 : 1); ++rep)
            hipLaunchKernelGGL(fwd_megakernel, dim3(grid), dim3(NTHR), LDS_BYTES, stream, p);
#ifdef PROBE_GROUP
        if (ph == 13) {
            (void)hipMemsetAsync((char*)d_ws + WS_CTL, 0, 1 * MiB, stream);
            for (int ph2 = 9; ph2 <= 13; ++ph2) { p.ph_lo = ph2; p.ph_hi = ph2 + 1; hipLaunchKernelGGL(fwd_megakernel, dim3(grid), dim3(NTHR), LDS_BYTES, stream, p); }
        }
#endif
    }
#else
    p.ph_lo = 0; p.ph_hi = NPHASE;
    void* args[] = {&p};
    hipError_t e = hipLaunchCooperativeKernel((const void*)fwd_megakernel, dim3(grid), dim3(NTHR), args, LDS_BYTES, stream);
    if (e != hipSuccess) fprintf(stderr, "cooperative launch failed: %s (grid %d)\n", hipGetErrorString(e), grid);
#endif
}
```

```cpp
#include <hip/hip_runtime.h>
#include <hip/hip_cooperative_groups.h>
#include <cstdint>
#include <cstdio>
namespace cg = cooperative_groups;

#ifndef MK_MULTI
#define MK_MULTI 0
#endif
#define PROBE_MASK 0u

#define DI __device__ __forceinline__
typedef unsigned short bf16_t;
typedef short bf16x8 __attribute__((ext_vector_type(8)));
typedef short s16x4 __attribute__((ext_vector_type(4)));
typedef float f32x4 __attribute__((ext_vector_type(4)));
typedef float f32x16 __attribute__((ext_vector_type(16)));
typedef unsigned u32x4 __attribute__((ext_vector_type(4)));
typedef unsigned u32x2 __attribute__((ext_vector_type(2)));

constexpr int S = 16384, DM = 1024, DFF = 2816;
constexpr int NTHR = 512;
constexpr size_t MiB = 1u << 20;
constexpr size_t WS_CTL = 0;
constexpr size_t WS_COSM = 1 * MiB, WS_SINM = 3 * MiB;
constexpr size_t WS_COSB = 5 * MiB, WS_SINB = 6 * MiB;
constexpr size_t WS_KMH = 7 * MiB, WS_KML = 7 * MiB + 131072;
constexpr size_t WS_W1_QKV = 8 * MiB, WS_W1_O = 14 * MiB, WS_W1_IN = 16 * MiB, WS_W1_OUT = 27 * MiB;
constexpr size_t WS_W0_DQKV = 33 * MiB, WS_W0_UQ = 35 * MiB, WS_W0_UKV = 37 * MiB, WS_W0_O = 38 * MiB, WS_W0_IN = 40 * MiB, WS_W0_OUT = 51 * MiB;
constexpr size_t WS_XB = 57 * MiB;
constexpr size_t WS_R = 89 * MiB;
constexpr size_t WS_AO = WS_R, WS_LAT = WS_R + 32 * MiB, WS_KR = WS_R + 52 * MiB, WS_Q = WS_R + 54 * MiB, WS_KV = WS_R + 102 * MiB;
constexpr size_t WS_Y = WS_R + 102 * MiB;
constexpr size_t WS_H = WS_R;
constexpr size_t WS_ML = 33 * MiB;
constexpr size_t WS_LIST = 36 * MiB;
constexpr size_t WS_PART = 57 * MiB;
constexpr size_t WS_QKV = 153 * MiB;
constexpr size_t WS_Y1 = 89 * MiB;
constexpr size_t WS_END = 256 * MiB;
constexpr int CTL_CNT = 16384;

constexpr int LDS_BYTES = 131072 + 8192;
extern __shared__ __attribute__((aligned(16))) unsigned char g_lds[];

struct Params { const float* in[15]; float* out; unsigned char* ws; int ph_lo, ph_hi; };

DI unsigned cvtpk(float lo, float hi) { unsigned r; asm("v_cvt_pk_bf16_f32 %0, %1, %2" : "=v"(r) : "v"(lo), "v"(hi)); return r; }
DI float bf2f(unsigned short v) { return __uint_as_float((unsigned)v << 16); }
DI int crow(int r, int hi) { return (r & 3) + 8 * (r >> 2) + 4 * hi; }
DI float wave_sum(float v) {
#pragma unroll
    for (int o = 1; o < 64; o <<= 1) v += __shfl_xor(v, o);
    return v;
}

__device__ const double kInvFreq[32] = {1.0, 0.6636012376960885, 0.44036660267178046, 0.2922278225730151, 0.19392274474868576, 0.12868737343265052, 0.08539710028576561, 0.05666962144529105, 0.03760603093086393, 0.024955408670558694, 0.016560440080994446, 0.010989528534539826, 0.007292664737217109, 0.004839421345719893, 0.003211445994752591, 0.0021311195369119653, 0.001414213562373095, 0.0009384738703573802, 0.000622772421914596, 0.0004132725499855165, 0.0002742481756762073, 0.00018199142881462546, 0.00012076973741146504, 8.01429472224798e-05, 5.318295896944988e-05, 3.529227739646723e-05, 2.341999896140934e-05, 1.5541540297632344e-05, 1.031338537721246e-05, 6.8439753011549275e-06, 4.5416704806078695e-06, 3.013858152139171e-06};

DI int srcmap(int code, int n) {
    switch (code) {
        case 1: { if (n < 640) return n; if (n < 704) { int j = n - 640; return 640 + (j >> 1) + 32 * (j & 1); } return -1; }
        case 2: { int h = n / 192, c = n - h * 192; if (c < 128) return n; int j = c - 128; return h * 192 + 128 + (j >> 1) + 32 * (j & 1); }
        case 3: { if (n >= 2048) return n; int c = n & 127; if (c >= 32) return n; return (n & ~127) + (c >> 1) + 16 * (c & 1); }
        case 4: { int q = n >> 5, t = (n >> 4) & 1, i = n & 15; return t * DFF + 16 * q + i; }
        default: return n;
    }
}
DI void wtrans(const float* __restrict__ W, int K, int N, bf16_t* __restrict__ Wt, int Np, int code, const float* __restrict__ kscale) {
    float* tile = (float*)g_lds;
    const int tid = threadIdx.x;
    const int tk = K / 64, tn = Np / 64, nt = tk * tn;
    for (int t = blockIdx.x; t < nt; t += gridDim.x) {
        const int n0 = (t / tk) * 64, k0 = (t % tk) * 64;
        __syncthreads();
        {
            const int nn = tid & 63; const int src = srcmap(code, n0 + nn);
#pragma unroll
            for (int i = 0; i < 8; ++i) {
                const int kk = (tid >> 6) + 8 * i;
                float v = 0.f;
                if (src >= 0) { v = W[(size_t)(k0 + kk) * N + src]; if (kscale) v *= kscale[k0 + kk]; }
                tile[kk * 65 + nn] = v;
            }
        }
        __syncthreads();
        {
            const int kk = (tid & 31) * 2;
#pragma unroll
            for (int i = 0; i < 4; ++i) {
                const int nn = (tid >> 5) + 16 * i;
                *(unsigned*)(Wt + (size_t)(n0 + nn) * K + k0 + kk) = cvtpk(tile[kk * 65 + nn], tile[(kk + 1) * 65 + nn]);
            }
        }
    }
}

DI void prep_phase(const Params& P) {
    unsigned char* ws = P.ws;
    const int tid = threadIdx.x;
    const size_t gt = (size_t)blockIdx.x * NTHR + tid, gs = (size_t)gridDim.x * NTHR;
    {
        const float* x = P.in[0]; bf16_t* xb = (bf16_t*)(ws + WS_XB);
        for (size_t i = gt; i < (size_t)S * DM / 8; i += gs) {
            const f32x4 a = *(const f32x4*)(x + i * 8), b = *(const f32x4*)(x + i * 8 + 4);
            u32x4 w = {cvtpk(a[0], a[1]), cvtpk(a[2], a[3]), cvtpk(b[0], b[1]), cvtpk(b[2], b[3])};
            *(u32x4*)(xb + i * 8) = w;
        }
    }
    {
        float* cm = (float*)(ws + WS_COSM); float* sm = (float*)(ws + WS_SINM); float* cb = (float*)(ws + WS_COSB); float* sb = (float*)(ws + WS_SINB);
        for (size_t i = gt; i < (size_t)S * 32; i += gs) {
            const int pos = (int)(i >> 5), f = (int)(i & 31);
            const double rev = (double)pos * kInvFreq[f] * 0.15915494309189535;
            const float fr = (float)(rev - floor(rev));
            const float c = __builtin_amdgcn_cosf(fr), s = __builtin_amdgcn_sinf(fr);
            cm[i] = c; sm[i] = s;
            if ((f & 1) == 0) { cb[pos * 16 + (f >> 1)] = c; sb[pos * 16 + (f >> 1)] = s; }
        }
    }
    wtrans(P.in[1], 1024, 704, (bf16_t*)(ws + WS_W0_DQKV), 768, 1, nullptr);
    wtrans(P.in[3], 384, 1536, (bf16_t*)(ws + WS_W0_UQ), 1536, 2, P.in[2]);
    wtrans(P.in[5], 256, 2048, (bf16_t*)(ws + WS_W0_UKV), 2048, 0, P.in[4]);
    wtrans(P.in[6], 1024, 1024, (bf16_t*)(ws + WS_W0_O), 1024, 0, nullptr);
    wtrans(P.in[7], 1024, 3072, (bf16_t*)(ws + WS_W1_QKV), 3072, 3, nullptr);
    wtrans(P.in[8], 1024, 1024, (bf16_t*)(ws + WS_W1_O), 1024, 0, nullptr);
    wtrans(P.in[9], 1024, 2 * DFF, (bf16_t*)(ws + WS_W0_IN), 2 * DFF, 4, nullptr);
    wtrans(P.in[9] + (size_t)1024 * 2 * DFF, 1024, 2 * DFF, (bf16_t*)(ws + WS_W1_IN), 2 * DFF, 4, nullptr);
    wtrans(P.in[10], DFF, 1024, (bf16_t*)(ws + WS_W0_OUT), 1024, 0, nullptr);
    wtrans(P.in[10] + (size_t)DFF * 1024, DFF, 1024, (bf16_t*)(ws + WS_W1_OUT), 1024, 0, nullptr);
}

DI void ln_phase(const float* __restrict__ Y, const float* __restrict__ g, const float* __restrict__ b, float* __restrict__ XF, bf16_t* __restrict__ XBo) {
    const int tid = threadIdx.x, wave = tid >> 6, lane = tid & 63;
    for (int row = blockIdx.x * 8 + wave; row < S; row += gridDim.x * 8) {
        const f32x4* yr = (const f32x4*)(Y + (size_t)row * DM);
        f32x4 v[4];
#pragma unroll
        for (int i = 0; i < 4; ++i) v[i] = yr[lane + 64 * i];
        float s = 0.f;
#pragma unroll
        for (int i = 0; i < 4; ++i) s += (v[i][0] + v[i][1]) + (v[i][2] + v[i][3]);
        s = wave_sum(s);
        const float mean = s * (1.0f / DM);
        float q = 0.f;
#pragma unroll
        for (int i = 0; i < 4; ++i) { const f32x4 d = v[i] - mean; q += (d[0] * d[0] + d[1] * d[1]) + (d[2] * d[2] + d[3] * d[3]); }
        q = wave_sum(q);
        const float rstd = rsqrtf(q * (1.0f / DM) + 1e-5f);
#pragma unroll
        for (int i = 0; i < 4; ++i) {
            const int col = (lane + 64 * i) * 4;
            const f32x4 gg = *(const f32x4*)(g + col), bb = *(const f32x4*)(b + col);
            const f32x4 o = (v[i] - mean) * rstd * gg + bb;
            *(f32x4*)(XF + (size_t)row * DM + col) = o;
            if (XBo) { u32x2 w = {cvtpk(o[0], o[1]), cvtpk(o[2], o[3])}; *(u32x2*)(XBo + (size_t)row * DM + col) = w; }
        }
    }
}

constexpr int BM = 256, BK = 64, HALF = 128, HT = HALF * BK, NXCD = 8, WGM = 8;
DI int lds_byte(int r, int c) { int st = (r >> 4) * 2 + (c >> 5), rr = r & 15, cc = c & 31, ob = rr * 64 + cc * 2; return st * 1024 + (ob ^ (((ob >> 9) & 1) << 5)); }
DI void stage_rc(int b, int& R, int& C) { int st = b / 1024, sb = b % 1024, swz = sb ^ (((sb >> 9) & 1) << 5); R = (st >> 1) * 16 + swz / 64; C = (st & 1) * 32 + (swz % 64) / 2; }

#define LAS __attribute__((address_space(3)))
template <class Epi>
DI void gemm_tile(const bf16_t* __restrict__ A, int lda, const bf16_t* __restrict__ Bt, int K, int pm, int pn, const Epi& epi) {
    LAS unsigned char* lds = (LAS unsigned char*)g_lds;
    constexpr int HTB = HT * 2;
#define SA(b, h) (((b) * 2 + (h)) * HTB)
#define SB(b, h) ((4 + (b) * 2 + (h)) * HTB)
#define STAGE(bufoff, gbase, voff) do { _Pragma("unroll") for (int _i = 0; _i < 2; ++_i) \
        __builtin_amdgcn_global_load_lds((const unsigned*)((const char*)(gbase) + (voff)[_i]), (LAS unsigned*)(lds + (bufoff) + ldsw + _i * 8192), 16, 0, 0); } while (0)
#define LDA(dst, b, h) do { _Pragma("unroll") for (int m = 0; m < 4; ++m) _Pragma("unroll") for (int k = 0; k < 2; ++k) dst[m][k] = *(const LAS bf16x8*)(lds + SA(b, h) + aoff + m * 2048 + k * 1024); } while (0)
#define LDB(dst, b, h) do { _Pragma("unroll") for (int n = 0; n < 2; ++n) _Pragma("unroll") for (int k = 0; k < 2; ++k) dst[n][k] = *(const LAS bf16x8*)(lds + SB(b, h) + boff + n * 2048 + k * 1024); } while (0)
#define MMA(ai, bj, At_, Bt_) do { __builtin_amdgcn_s_setprio(1); \
    _Pragma("unroll") for (int m = 0; m < 4; ++m) _Pragma("unroll") for (int n = 0; n < 2; ++n) _Pragma("unroll") for (int k = 0; k < 2; ++k) \
      acc[ai][bj][m][n] = __builtin_amdgcn_mfma_f32_16x16x32_bf16(Bt_[n][k], At_[m][k], acc[ai][bj][m][n], 0, 0, 0); \
    __builtin_amdgcn_s_setprio(0); } while (0)
#define WAIT_V(n) asm volatile("s_waitcnt vmcnt(" #n ")" ::: "memory")
#define WAIT_L(n) asm volatile("s_waitcnt lgkmcnt(" #n ")" ::: "memory")
#define BAR __builtin_amdgcn_s_barrier()
#define SCHED __builtin_amdgcn_sched_barrier(0)
    __syncthreads();
    epi.pre(pm);
    int tid = threadIdx.x; asm volatile("" : "+v"(tid));
    const int wid = __builtin_amdgcn_readfirstlane(tid >> 6), lane = tid & 63, wr = wid >> 2, wc = wid & 3, fr = lane & 15, fq = lane >> 4;
    unsigned voffA[2], voffB[2];
#pragma unroll
    for (int i = 0; i < 2; ++i) { int R, C; stage_rc(tid * 16 + i * 8192, R, C); voffA[i] = (unsigned)(R * lda + C) * 2u; voffB[i] = (unsigned)(R * K + C) * 2u; }
    const size_t kstep = (size_t)(BK * 2), hA = (size_t)HALF * lda * 2, hB = (size_t)HALF * K * 2;
    const unsigned ldsw = (unsigned)wid * 1024u;
    const int aoff = lds_byte(wr * 64 + fr, fq * 8), boff = lds_byte(wc * 32 + fr, fq * 8);
    const char* cA = (const char*)A + (size_t)pm * 2 * hA; const char* cB = (const char*)Bt + (size_t)pn * 2 * hB;
    f32x4 acc[2][2][4][2];
#pragma unroll
    for (int a = 0; a < 2; ++a)
#pragma unroll
        for (int b = 0; b < 2; ++b)
#pragma unroll
            for (int m = 0; m < 4; ++m)
#pragma unroll
                for (int n = 0; n < 2; ++n) acc[a][b][m][n] = (f32x4){0.f, 0.f, 0.f, 0.f};
    bf16x8 At[4][2], B0[2][2], B1[2][2];
    const int nt = K / BK;
    STAGE(SB(0, 0), cB, voffB); STAGE(SA(0, 0), cA, voffA); STAGE(SB(0, 1), cB + hB, voffB); STAGE(SA(0, 1), cA + hA, voffA);
    if (wr == 1) BAR;
    WAIT_V(4); BAR;
    STAGE(SB(1, 0), cB + kstep, voffB); STAGE(SA(1, 0), cA + kstep, voffA); STAGE(SB(1, 1), cB + hB + kstep, voffB);
    WAIT_V(6); BAR;
    for (int t = 0; t < nt - 2; t += 2) {
        const char* a1 = cA + (size_t)(t + 1) * kstep;
        const char* a2 = cA + (size_t)(t + 2) * kstep; const char* b2 = cB + (size_t)(t + 2) * kstep;
        const char* a3 = a2 + kstep; const char* b3 = b2 + kstep;
        LDB(B0, 0, 0); SCHED; LDA(At, 0, 0); STAGE(SA(1, 1), a1 + hA, voffA);
        WAIT_L(8); BAR; WAIT_L(0); MMA(0, 0, At, B0); BAR; SCHED;
        LDB(B1, 0, 1); STAGE(SB(0, 0), b2, voffB);
        BAR; WAIT_L(0); MMA(0, 1, At, B1); BAR;
        LDA(At, 0, 1); STAGE(SA(0, 0), a2, voffA);
        BAR; WAIT_L(0); MMA(1, 0, At, B0); BAR; SCHED;
        STAGE(SB(0, 1), b2 + hB, voffB);
        WAIT_V(6); BAR; MMA(1, 1, At, B1); BAR;
        LDB(B0, 1, 0); SCHED; LDA(At, 1, 0); STAGE(SA(0, 1), a2 + hA, voffA);
        WAIT_L(8); BAR; WAIT_L(0); MMA(0, 0, At, B0); BAR; SCHED;
        LDB(B1, 1, 1); STAGE(SB(1, 0), b3, voffB);
        BAR; WAIT_L(0); MMA(0, 1, At, B1); BAR;
        LDA(At, 1, 1); STAGE(SA(1, 0), a3, voffA);
        BAR; WAIT_L(0); MMA(1, 0, At, B0); BAR; SCHED;
        STAGE(SB(1, 1), b3 + hB, voffB);
        WAIT_V(6); BAR; MMA(1, 1, At, B1); BAR;
    }
    { LDB(B0, 0, 0); LDA(At, 0, 0); STAGE(SA(1, 1), cA + (size_t)(nt - 1) * kstep + hA, voffA);
      BAR; WAIT_L(0); MMA(0, 0, At, B0); BAR;
      LDB(B1, 0, 1); BAR; WAIT_L(0); MMA(0, 1, At, B1); BAR;
      LDA(At, 0, 1); WAIT_V(4); BAR; WAIT_L(0); MMA(1, 0, At, B0); MMA(1, 1, At, B1); BAR; }
    { LDB(B0, 1, 0); LDA(At, 1, 0); WAIT_V(2); BAR; WAIT_L(0); MMA(0, 0, At, B0); BAR;
      LDB(B1, 1, 1); WAIT_V(0); BAR; WAIT_L(0); MMA(0, 1, At, B1); BAR;
      LDA(At, 1, 1); BAR; WAIT_L(0); MMA(1, 0, At, B0); MMA(1, 1, At, B1); BAR; }
    if (wr == 0) BAR;
    epi(acc, pm, pn, wr, wc, fr, fq);
#undef SA
#undef SB
#undef STAGE
#undef LDA
#undef LDB
#undef MMA
}

template <class Epi>
DI void gemm_phase(const bf16_t* A, int lda, const bf16_t* Bt, int K, int nM, int nN, const Epi& epi, int cshift = 0) {
    const int nwg = nM * nN, G = gridDim.x;
    const int c = ((int)blockIdx.x + cshift) % G;
    for (int i = 0;; ++i) {
        const long L = (long)i * G + c; if (L >= nwg) break;
        int wgid = (int)L;
        { const int q = nwg / NXCD, r = nwg % NXCD, xcd = wgid % NXCD, off = wgid / NXCD; wgid = (xcd < r ? xcd * (q + 1) : r * (q + 1) + (xcd - r) * q) + off; }
        const int nig = WGM * nN, gid = wgid / nig, fm = gid * WGM, gsz = (nM - fm) < WGM ? (nM - fm) : WGM;
        const int pm = fm + ((wgid % nig) % gsz), pn = (wgid % nig) / gsz;
        gemm_tile<Epi>(A, lda, Bt, K, pm, pn, epi);
    }
}

#define EPI_LOOP_BEGIN \
    _Pragma("unroll") for (int ai = 0; ai < 2; ++ai) _Pragma("unroll") for (int m = 0; m < 4; ++m) { \
        const int rl = ai * HALF + wr * 64 + m * 16 + fr; const int row = pm * BM + rl; (void)rl; \
        _Pragma("unroll") for (int bj = 0; bj < 2; ++bj) _Pragma("unroll") for (int n = 0; n < 2; ++n) { \
            const int col = pn * BM + bj * HALF + wc * 32 + n * 16 + fq * 4; f32x4 v = acc[ai][bj][m][n];
#define EPI_LOOP_END } }

DI void st_bf4(bf16_t* p, f32x4 v) { u32x2 w = {cvtpk(v[0], v[1]), cvtpk(v[2], v[3])}; *(u32x2*)p = w; }
DI f32x4 rope4(f32x4 v, const float* ct, const float* st) {
    const float c0 = ct[0], s0 = st[0], c1 = ct[1], s1 = st[1];
    return (f32x4){v[0] * c0 - v[1] * s0, v[1] * c0 + v[0] * s0, v[2] * c1 - v[3] * s1, v[3] * c1 + v[2] * s1};
}

struct EpiLat {
    bf16_t* LAT; bf16_t* KR; const float* cosM; const float* sinM;
    DI void pre(int) const {}
    DI void operator()(const f32x4 (&acc)[2][2][4][2], int pm, int pn, int wr, int wc, int fr, int fq) const {
        EPI_LOOP_BEGIN
            if (col < 640) st_bf4(LAT + (size_t)row * 640 + col, v);
            else if (col < 704) { const int i0 = (col - 640) >> 1; st_bf4(KR + (size_t)row * 64 + (col - 640), rope4(v, cosM + row * 32 + i0, sinM + row * 32 + i0)); }
        EPI_LOOP_END
    }
};
constexpr float QSCALE_A = 0.10411754627697264f;
constexpr float QSCALE_B = 0.12751743082459868f;
template <int KK> DI void rs_pre(const bf16_t* A, int lda, int pm) {
    float* rs = (float*)(g_lds + 131072);
    int tid = threadIdx.x; asm volatile("" : "+v"(tid));
    const int row = tid >> 1, half = tid & 1;
    const bf16_t* p = A + (size_t)(pm * BM + row) * lda + half * (KK / 2);
    float ss = 0.f;
#pragma unroll 4
    for (int i = 0; i < KK / 16; ++i) {
        const bf16x8 v = *(const bf16x8*)(p + i * 8);
#pragma unroll
        for (int j = 0; j < 8; ++j) { const float f = bf2f((unsigned short)v[j]); ss += f * f; }
    }
    ss += __shfl_xor(ss, 1);
    if (!half) rs[row] = rsqrtf(ss * (1.0f / KK) + 1e-6f);
}
struct EpiQ {
    const bf16_t* A; bf16_t* Q; const float* cosM; const float* sinM;
    DI void pre(int pm) const { rs_pre<384>(A, 640, pm); }
    DI void operator()(const f32x4 (&acc)[2][2][4][2], int pm, int pn, int wr, int wc, int fr, int fq) const {
        const float* rs = (const float*)(g_lds + 131072);
        EPI_LOOP_BEGIN
            v = v * (rs[rl] * QSCALE_A);
            const int c = col % 192;
            if (c >= 128) { const int i0 = (c - 128) >> 1; v = rope4(v, cosM + row * 32 + i0, sinM + row * 32 + i0); }
            st_bf4(Q + (size_t)row * 1536 + col, v);
        EPI_LOOP_END
    }
};
struct EpiKV {
    const bf16_t* A; bf16_t* KV;
    DI void pre(int pm) const { rs_pre<256>(A, 640, pm); }
    DI void operator()(const f32x4 (&acc)[2][2][4][2], int pm, int pn, int wr, int wc, int fr, int fq) const {
        const float* rs = (const float*)(g_lds + 131072);
        EPI_LOOP_BEGIN
            v = v * rs[rl];
            st_bf4(KV + (size_t)row * 2048 + col, v);
        EPI_LOOP_END
    }
};
struct EpiRes {
    const float* R; float* Y;
    DI void pre(int) const {}
    DI void operator()(const f32x4 (&acc)[2][2][4][2], int pm, int pn, int wr, int wc, int fr, int fq) const {
        EPI_LOOP_BEGIN
            const f32x4 r = *(const f32x4*)(R + (size_t)row * DM + col);
            *(f32x4*)(Y + (size_t)row * DM + col) = r * 1.4142135623730951f + v;
        EPI_LOOP_END
    }
};
struct EpiSwiglu {
    bf16_t* H;
    DI void pre(int) const {}
    DI void operator()(const f32x4 (&acc)[2][2][4][2], int pm, int pn, int wr, int wc, int fr, int fq) const {
#pragma unroll
        for (int ai = 0; ai < 2; ++ai)
#pragma unroll
            for (int m = 0; m < 4; ++m) {
                const int row = pm * BM + ai * HALF + wr * 64 + m * 16 + fr;
#pragma unroll
                for (int bj = 0; bj < 2; ++bj) {
                    const f32x4 g = acc[ai][bj][m][0], u = acc[ai][bj][m][1];
                    f32x4 h;
#pragma unroll
                    for (int j = 0; j < 4; ++j) h[j] = g[j] * __builtin_amdgcn_rcpf(1.0f + __builtin_amdgcn_exp2f(-1.4426950408889634f * g[j])) * u[j];
                    st_bf4(H + (size_t)row * DFF + pn * 128 + bj * 64 + wc * 16 + fq * 4, h);
                }
            }
    }
};
struct EpiMobaQKV {
    bf16_t* QKV; const float* cosB; const float* sinB;
    DI void pre(int) const {}
    DI void operator()(const f32x4 (&acc)[2][2][4][2], int pm, int pn, int wr, int wc, int fr, int fq) const {
        EPI_LOOP_BEGIN
            if (col < 2048) { const int c = col & 127; if (c < 32) { const int i0 = c >> 1; v = rope4(v, cosB + row * 16 + i0, sinB + row * 16 + i0); } }
            if (col < 1024) v = v * QSCALE_B;
            st_bf4(QKV + (size_t)row * 3072 + col, v);
        EPI_LOOP_END
    }
};

constexpr int AL_K0 = 0, AL_KB = 24576, AL_V0 = 49152, AL_VB = 16384, AL_W = 81920;
#define MFMA32(a, b, c) __builtin_amdgcn_mfma_f32_32x32x16_bf16((a), (b), (c), 0, 0, 0)
DI void dma16(const void* g, unsigned ldsoff) {
    __builtin_amdgcn_global_load_lds((const unsigned*)g, (LAS unsigned*)((LAS unsigned char*)g_lds + ldsoff), 16, 0, 0);
}
DI bf16x8 pack8(const f32x16& x, int s) {
    u32x4 w = {cvtpk(x[8 * s], x[8 * s + 1]), cvtpk(x[8 * s + 2], x[8 * s + 3]), cvtpk(x[8 * s + 4], x[8 * s + 5]), cvtpk(x[8 * s + 6], x[8 * s + 7])};
    return __builtin_bit_cast(bf16x8, w);
}
template <int ND> struct KBase { int b[ND == 12 ? 4 : 8]; };
template <int ND> DI KBase<ND> make_kbase(int r32, int hi) {
    KBase<ND> k;
    if constexpr (ND == 12) {
#pragma unroll
        for (int dd = 0; dd < 4; ++dd) k.b[dd] = r32 * 384 + (((dd * 2 + hi) ^ ((r32 >> 1) & 7)) << 4);
    } else {
#pragma unroll
        for (int dd = 0; dd < 8; ++dd) k.b[dd] = r32 * 256 + (((dd * 2 + hi) ^ (r32 & 15)) << 4);
    }
    return k;
}
DI unsigned v_lane_base(int lane) {
    const int i16 = lane & 15, g = lane >> 4, rowq = i16 >> 2, pp = i16 & 3, colblk = g & 1, hi = g >> 1;
    return (unsigned)(hi * 1024 + rowq * 64 + colblk * 32 + pp * 8);
}
template <int ND>
DI void attn_tile(int kbuf_off, unsigned vb, const KBase<ND>& kb, const bf16x8* qr, f32x16 (&o)[4], float& m, float& l, bool domask, int qrel, float* alw, int r32, int hi) {
    f32x16 p0 = {}, p1 = {};
    constexpr int RS = (ND == 12) ? 384 : 256;
    const unsigned char* kbuf = g_lds + kbuf_off;
#pragma unroll
    for (int dg = 0; dg < ND / 2; ++dg) {
        bf16x8 b0[2], b1[2];
#pragma unroll
        for (int i = 0; i < 2; ++i) {
            const int d0 = dg * 2 + i;
            const unsigned char* a = (ND == 12) ? (kbuf + kb.b[d0 & 3] + (d0 >> 2) * 128) : (kbuf + kb.b[d0 & 7]);
            b0[i] = *(const bf16x8*)a; b1[i] = *(const bf16x8*)(a + 32 * RS);
        }
#pragma unroll
        for (int i = 0; i < 2; ++i) { p0 = MFMA32(b0[i], qr[dg * 2 + i], p0); p1 = MFMA32(b1[i], qr[dg * 2 + i], p1); }
        __builtin_amdgcn_sched_barrier(0);
    }
    if (domask) {
        const float NEG = -__builtin_inff();
#pragma unroll
        for (int r = 0; r < 16; ++r) { const int k0 = (r & 3) + 8 * (r >> 2) + 4 * hi; if (k0 > qrel) p0[r] = NEG; if (k0 + 32 > qrel) p1[r] = NEG; }
    }
    float mx = p0[0];
#pragma unroll
    for (int r = 1; r < 16; ++r) mx = fmaxf(mx, p0[r]);
#pragma unroll
    for (int r = 0; r < 16; ++r) mx = fmaxf(mx, p1[r]);
    mx = fmaxf(mx, __shfl_xor(mx, 32));
    if (!__all(mx - m <= 11.0f)) {
        const float mn = fmaxf(m, mx);
        const float alpha = __builtin_amdgcn_exp2f(m - mn);
        m = mn; l *= alpha;
        if (hi == 0) alw[r32] = alpha;
        asm volatile("s_waitcnt lgkmcnt(0)" ::: "memory");
#pragma unroll
        for (int r = 0; r < 16; ++r) { const float a = alw[crow(r, hi)];
#pragma unroll
            for (int d0 = 0; d0 < 4; ++d0) o[d0][r] *= a; }
        asm volatile("s_waitcnt lgkmcnt(0)" ::: "memory");
    }
    float ps = 0.f;
#pragma unroll
    for (int r = 0; r < 16; ++r) { p0[r] = __builtin_amdgcn_exp2f(p0[r] - m); ps += p0[r]; }
#pragma unroll
    for (int r = 0; r < 16; ++r) { p1[r] = __builtin_amdgcn_exp2f(p1[r] - m); ps += p1[r]; }
    l += ps;
    const bf16x8 pa0 = pack8(p0, 0), pa1 = pack8(p0, 1), pa2 = pack8(p1, 0), pa3 = pack8(p1, 1);
#define TRRD(dst, off) asm volatile("ds_read_b64_tr_b16 %0, %1 offset:%2" : "=&v"(dst) : "v"(vb), "i"(off) : "memory")
#define PV_D0(d0) do { s16x4 l0, l1, h0, h1; constexpr int b_ = (d0) * 256; \
        TRRD(l0, b_); TRRD(h0, b_ + 2048); TRRD(l1, b_ + 4096); TRRD(h1, b_ + 6144); \
        asm volatile("s_waitcnt lgkmcnt(0)" ::: "memory"); __builtin_amdgcn_sched_barrier(0); \
        o[d0] = MFMA32(pa0, ((bf16x8){l0[0], l0[1], l0[2], l0[3], h0[0], h0[1], h0[2], h0[3]}), o[d0]); \
        o[d0] = MFMA32(pa1, ((bf16x8){l1[0], l1[1], l1[2], l1[3], h1[0], h1[1], h1[2], h1[3]}), o[d0]); \
        TRRD(l0, b_ + 8192); TRRD(h0, b_ + 10240); TRRD(l1, b_ + 12288); TRRD(h1, b_ + 14336); \
        asm volatile("s_waitcnt lgkmcnt(0)" ::: "memory"); __builtin_amdgcn_sched_barrier(0); \
        o[d0] = MFMA32(pa2, ((bf16x8){l0[0], l0[1], l0[2], l0[3], h0[0], h0[1], h0[2], h0[3]}), o[d0]); \
        o[d0] = MFMA32(pa3, ((bf16x8){l1[0], l1[1], l1[2], l1[3], h1[0], h1[1], h1[2], h1[3]}), o[d0]); } while (0)
    PV_D0(0); PV_D0(1); PV_D0(2); PV_D0(3);
#undef PV_D0
#undef TRRD
}
#define VM_DRAIN() asm volatile("s_waitcnt vmcnt(0)" ::: "memory")

DI void mla_block(const bf16_t* __restrict__ Q, const bf16_t* __restrict__ KV, const bf16_t* __restrict__ KR, bf16_t* __restrict__ AO, int h, int qb) {
    int tid = threadIdx.x; asm volatile("" : "+v"(tid));
    const int w = __builtin_amdgcn_readfirstlane(tid >> 6), lane = tid & 63, r32 = lane & 31, hi = lane >> 5;
    float* alw = (float*)(g_lds + AL_W + w * 512);
    const int NT = 4 * qb + 4, tmax = 4 * qb + (w >> 1);
    const int row = qb * 256 + w * 32 + r32;
    bf16x8 qr[12];
    { const bf16_t* qp = Q + (size_t)row * 1536 + h * 192 + hi * 8;
#pragma unroll
      for (int d0 = 0; d0 < 12; ++d0) qr[d0] = *(const bf16x8*)(qp + d0 * 16); }
    int ksrc[3], vsrc[2];
#pragma unroll
    for (int i = 0; i < 3; ++i) { const int b = (i * 8 + w) * 1024 + lane * 16, kr = b / 384, pc = (b - kr * 384) >> 4, c = pc ^ ((kr >> 1) & 7);
        ksrc[i] = (c < 16) ? (kr * 2048 + h * 256 + c * 8) : -(kr * 64 + (c - 16) * 8) - 1; }
#pragma unroll
    for (int i = 0; i < 2; ++i) { const int key = (i * 8 + w) * 4 + ((lane >> 2) & 3), col = (lane >> 4) * 32 + (lane & 3) * 8; vsrc[i] = key * 2048 + h * 256 + 128 + col; }
#define MLA_ISSUE(t_, b_) do { const bf16_t* kvb_ = KV + (size_t)(t_) * 64 * 2048; const bf16_t* krb_ = KR + (size_t)(t_) * 64 * 64; \
    _Pragma("unroll") for (int i = 0; i < 3; ++i) dma16((ksrc[i] >= 0) ? (const void*)(kvb_ + ksrc[i]) : (const void*)(krb_ + (-ksrc[i] - 1)), AL_K0 + (b_) * AL_KB + (i * 8 + w) * 1024); \
    _Pragma("unroll") for (int i = 0; i < 2; ++i) dma16(kvb_ + vsrc[i], AL_V0 + (b_) * AL_VB + (i * 8 + w) * 1024); } while (0)
    f32x16 o[4] = {};
    float m = -1e30f, l = 0.f;
    const unsigned vb0 = (unsigned)(uintptr_t)(g_lds + AL_V0) + v_lane_base(lane);
    const KBase<12> kb = make_kbase<12>(r32, hi);
    MLA_ISSUE(0, 0); VM_DRAIN();
    __syncthreads();
#pragma unroll 1
    for (int t = 0; t < NT; ++t) {
        const int b = t & 1;
        if (t + 1 < NT) MLA_ISSUE(t + 1, b ^ 1);
        if (t <= tmax) attn_tile<12>(AL_K0 + b * AL_KB, vb0 + b * AL_VB, kb, qr, o, m, l, t == tmax, row - t * 64, alw, r32, hi);
        VM_DRAIN();
        __syncthreads();
    }
#undef MLA_ISSUE
    const float lt = l + __shfl_xor(l, 32);
    if (hi == 0) alw[r32] = __builtin_amdgcn_rcpf(lt);
    asm volatile("s_waitcnt lgkmcnt(0)" ::: "memory");
    bf16_t* Ow = AO + (size_t)(qb * 256 + w * 32) * 1024 + h * 128;
#pragma unroll
    for (int r = 0; r < 16; ++r) { const int orow = crow(r, hi); const float inv = alw[orow];
#pragma unroll
        for (int d0 = 0; d0 < 4; ++d0) { const float v = o[d0][r] * inv; const float vn = __shfl_xor(v, 1);
            if ((r32 & 1) == 0) *(unsigned*)(Ow + (size_t)orow * 1024 + d0 * 32 + r32) = cvtpk(v, vn); } }
    asm volatile("s_waitcnt lgkmcnt(0)" ::: "memory");
}
DI void mla_attn_phase(const Params& P) {
    const bf16_t* Q = (const bf16_t*)(P.ws + WS_Q); const bf16_t* KV = (const bf16_t*)(P.ws + WS_KV); const bf16_t* KR = (const bf16_t*)(P.ws + WS_KR);
    bf16_t* AO = (bf16_t*)(P.ws + WS_AO);
    for (int item = blockIdx.x; item < 256; item += gridDim.x) {
        const int h = item & 7, p = item >> 3;
#pragma unroll 1
        for (int sub = 0; sub < 2; ++sub) mla_block(Q, KV, KR, AO, h, sub ? p : 63 - p);
    }
}

DI void moba_kmean_phase(const Params& P) {
    const bf16_t* QKV = (const bf16_t*)(P.ws + WS_QKV); bf16_t* KMH = (bf16_t*)(P.ws + WS_KMH); bf16_t* KML = (bf16_t*)(P.ws + WS_KML);
    float* red = (float*)g_lds;
    const int tid = threadIdx.x, d = tid & 127, part = tid >> 7;
    for (int item = blockIdx.x; item < 512; item += gridDim.x) {
        const int h = item >> 6, j = item & 63;
        const bf16_t* kp = QKV + (size_t)(j * 256 + part * 64) * 3072 + 1024 + h * 128 + d;
        float s = 0.f;
        for (int i = 0; i < 64; ++i) s += bf2f(kp[(size_t)i * 3072]);
        __syncthreads();
        red[tid] = s;
        __syncthreads();
        if (tid < 128) {
            const float km = ((red[tid] + red[tid + 128]) + (red[tid + 256] + red[tid + 384])) * (1.0f / 256.0f);
            const unsigned hb = cvtpk(km, 0.f) & 0xffffu; const float hf = bf2f((unsigned short)hb);
            const unsigned lb = cvtpk(km - hf, 0.f) & 0xffffu;
            KMH[item * 128 + tid] = (bf16_t)hb; KML[item * 128 + tid] = (bf16_t)lb;
        }
    }
}
#define TOP3_INS(v_, i_) do { const float vv_ = (v_); const int ii_ = (i_); \
    if (vv_ > v1 || (vv_ == v1 && ii_ < i1)) { v3 = v2; i3 = i2; v2 = v1; i2 = i1; v1 = vv_; i1 = ii_; } \
    else if (vv_ > v2 || (vv_ == v2 && ii_ < i2)) { v3 = v2; i3 = i2; v2 = vv_; i2 = ii_; } \
    else if (vv_ > v3 || (vv_ == v3 && ii_ < i3)) { v3 = vv_; i3 = ii_; } } while (0)
DI void moba_gate_phase(const Params& P) {
    const bf16_t* QKV = (const bf16_t*)(P.ws + WS_QKV); const bf16_t* KMH = (const bf16_t*)(P.ws + WS_KMH); const bf16_t* KML = (const bf16_t*)(P.ws + WS_KML);
    unsigned* cnt = (unsigned*)(P.ws + WS_CTL) + CTL_CNT; unsigned short* list = (unsigned short*)(P.ws + WS_LIST); float2* ML = (float2*)(P.ws + WS_ML);
    const int tid = threadIdx.x, w = tid >> 6, lane = tid & 63, r32 = lane & 31, hi = lane >> 5;
    unsigned* lcnt = (unsigned*)g_lds; unsigned* lbase = lcnt + 64;
    for (int item = blockIdx.x; item < 512; item += gridDim.x) {
        const int h = item & 7, tq = item >> 3;
        const int q = tq * 256 + w * 32 + r32;
        float v1 = -3e38f, v2 = -3e38f, v3 = -3e38f; int i1 = 255, i2 = 255, i3 = 255;
        if (tq > 0) {
            bf16x8 qr[8];
            { const bf16_t* qp = QKV + (size_t)q * 3072 + h * 128 + hi * 8;
#pragma unroll
              for (int d0 = 0; d0 < 8; ++d0) qr[d0] = *(const bf16x8*)(qp + d0 * 16); }
#pragma unroll
            for (int u = 0; u < 2; ++u) {
                if (32 * u < tq) {
                    f32x16 g = {};
                    const size_t ko = (size_t)((h * 64 + 32 * u + r32) * 128 + hi * 8);
#pragma unroll
                    for (int d0 = 0; d0 < 8; ++d0) {
                        g = MFMA32(*(const bf16x8*)(KMH + ko + d0 * 16), qr[d0], g);
                        g = MFMA32(*(const bf16x8*)(KML + ko + d0 * 16), qr[d0], g);
                    }
#pragma unroll
                    for (int r = 0; r < 16; ++r) { const int blk = 32 * u + crow(r, hi); if (blk < tq) TOP3_INS(g[r], blk); }
                }
            }
            const float pv1 = __shfl_xor(v1, 32), pv2 = __shfl_xor(v2, 32), pv3 = __shfl_xor(v3, 32);
            const int pi1 = __shfl_xor(i1, 32), pi2 = __shfl_xor(i2, 32), pi3 = __shfl_xor(i3, 32);
            if (pi1 < 255) TOP3_INS(pv1, pi1);
            if (pi2 < 255) TOP3_INS(pv2, pi2);
            if (pi3 < 255) TOP3_INS(pv3, pi3);
        }
        __syncthreads();
        if (tid < 64) { lcnt[tid] = 0u; }
        __syncthreads();
        const int sel[3] = {i1, i2, i3};
        unsigned lpos[3] = {0u, 0u, 0u};
        if (hi == 0) {
#pragma unroll
            for (int s = 0; s < 3; ++s) {
                if (sel[s] < 255) lpos[s] = atomicAdd(&lcnt[sel[s]], 1u);
                else ML[(size_t)(q * 8 + h) * 3 + s] = make_float2(-1e30f, 0.f);
            }
        }
        __syncthreads();
        if (tid < 64) { const unsigned c = lcnt[tid]; lbase[tid] = c ? atomicAdd(&cnt[h * 64 + tid], c) : 0u; }
        __syncthreads();
        if (hi == 0) {
#pragma unroll
            for (int s = 0; s < 3; ++s)
                if (sel[s] < 255) list[(size_t)(h * 64 + sel[s]) * 16384 + lbase[sel[s]] + lpos[s]] = (unsigned short)((q << 2) | s);
        }
    }
}
#define MB_DECL int mb_k[2], mb_v[2]; \
    _Pragma("unroll") for (int i = 0; i < 2; ++i) { const int kr_ = (i * 8 + w) * 4 + (lane >> 4), c_ = (lane & 15) ^ (kr_ & 15); mb_k[i] = kr_ * 3072 + 1024 + c_ * 8; \
        const int key_ = (i * 8 + w) * 4 + ((lane >> 2) & 3), col_ = (lane >> 4) * 32 + (lane & 3) * 8; mb_v[i] = key_ * 3072 + 2048 + col_; }
#define MB_ISSUE(key0_, b_) do { const bf16_t* g_ = QKV + (size_t)(key0_) * 3072 + h * 128; \
    _Pragma("unroll") for (int i = 0; i < 2; ++i) { dma16(g_ + mb_k[i], AL_K0 + (b_) * AL_KB + (i * 8 + w) * 1024); dma16(g_ + mb_v[i], AL_V0 + (b_) * AL_VB + (i * 8 + w) * 1024); } } while (0)

DI void moba_sel_phase(const Params& P) {
    const bf16_t* QKV = (const bf16_t*)(P.ws + WS_QKV);
    const unsigned* cnt = (const unsigned*)(P.ws + WS_CTL) + CTL_CNT; const unsigned short* list = (const unsigned short*)(P.ws + WS_LIST);
    float2* ML = (float2*)(P.ws + WS_ML); bf16_t* PART = (bf16_t*)(P.ws + WS_PART);
    const int tid = threadIdx.x, w = __builtin_amdgcn_readfirstlane(tid >> 6), lane = tid & 63, r32 = lane & 31, hi = lane >> 5;
    int* pre = (int*)(g_lds + 100 * 1024);
    float* alw = (float*)(g_lds + AL_W + w * 512);
    unsigned* cdw = (unsigned*)(alw + 32);
    __syncthreads();
    pre[tid + 1] = (int)((__hip_atomic_load(cnt + tid, __ATOMIC_RELAXED, __HIP_MEMORY_SCOPE_AGENT) + 255u) >> 8);
    __syncthreads();
    if (tid == 0) { int a = 0; pre[0] = 0; for (int i = 1; i <= 512; ++i) { a += pre[i]; pre[i] = a; } }
    __syncthreads();
    const int T = pre[512];
    const unsigned vb0 = (unsigned)(uintptr_t)(g_lds + AL_V0) + v_lane_base(lane);
    const KBase<8> kb = make_kbase<8>(r32, hi);
    MB_DECL;
    for (int cid = blockIdx.x; cid < T; cid += gridDim.x) {
        int lo = 0, hi_ = 512;
        while (hi_ - lo > 1) { const int mid = (lo + hi_) >> 1; if (pre[mid] <= cid) lo = mid; else hi_ = mid; }
        const int hj = lo, h = hj >> 6, j = hj & 63, c = cid - pre[hj];
        const int n = (int)__hip_atomic_load(cnt + hj, __ATOMIC_RELAXED, __HIP_MEMORY_SCOPE_AGENT);
        const int e0 = c * 256 + w * 32;
        const bool wact = e0 < n;
        const bool valid = (e0 + r32) < n;
        const unsigned code = list[(size_t)hj * 16384 + (valid ? (e0 + r32) : (wact ? e0 : 0))];
        const int q = (int)(code >> 2), slot = (int)(code & 3);
        bf16x8 qr[8];
        { const bf16_t* qp = QKV + (size_t)q * 3072 + h * 128 + hi * 8;
#pragma unroll
          for (int d0 = 0; d0 < 8; ++d0) qr[d0] = *(const bf16x8*)(qp + d0 * 16); }
        f32x16 o[4] = {};
        float m = -1e30f, l = 0.f;
        MB_ISSUE(j * 256, 0); VM_DRAIN();
        __syncthreads();
#pragma unroll 1
        for (int t = 0; t < 4; ++t) {
            const int b = t & 1;
            if (t + 1 < 4) MB_ISSUE(j * 256 + (t + 1) * 64, b ^ 1);
            if (wact) attn_tile<8>(AL_K0 + b * AL_KB, vb0 + b * AL_VB, kb, qr, o, m, l, false, 0, alw, r32, hi);
            VM_DRAIN();
            __syncthreads();
        }
        if (wact) {
            const float lt = l + __shfl_xor(l, 32);
            if (hi == 0) { alw[r32] = __builtin_amdgcn_rcpf(lt); cdw[r32] = valid ? code : 0xffffffffu; if (valid) ML[(size_t)(q * 8 + h) * 3 + slot] = make_float2(m, lt); }
            asm volatile("s_waitcnt lgkmcnt(0)" ::: "memory");
#pragma unroll
            for (int r = 0; r < 16; ++r) { const int orow = crow(r, hi); const float inv = alw[orow]; const unsigned cd = cdw[orow];
                bf16_t* dst = PART + ((size_t)((cd >> 2) * 3 + (cd & 3)) * 8 + h) * 128;
#pragma unroll
                for (int d0 = 0; d0 < 4; ++d0) { const float v = o[d0][r] * inv; const float vn = __shfl_xor(v, 1);
                    if ((r32 & 1) == 0 && cd != 0xffffffffu) *(unsigned*)(dst + d0 * 32 + r32) = cvtpk(v, vn); } }
            asm volatile("s_waitcnt lgkmcnt(0)" ::: "memory");
        }
    }
}
DI void moba_own_phase(const Params& P) {
    bf16_t* QKV = (bf16_t*)(P.ws + WS_QKV);
    const float2* ML = (const float2*)(P.ws + WS_ML); const bf16_t* PART = (const bf16_t*)(P.ws + WS_PART);
    const int tid = threadIdx.x, w = __builtin_amdgcn_readfirstlane(tid >> 6), lane = tid & 63, r32 = lane & 31, hi = lane >> 5;
    float* alw = (float*)(g_lds + AL_W + w * 512);
    const unsigned vb0 = (unsigned)(uintptr_t)(g_lds + AL_V0) + v_lane_base(lane);
    const KBase<8> kb = make_kbase<8>(r32, hi);
    MB_DECL;
    for (int item = blockIdx.x; item < 512; item += gridDim.x) {
        const int h = item & 7, tq = item >> 3;
        const int q = tq * 256 + w * 32 + r32;
        bf16x8 qr[8];
        { const bf16_t* qp = QKV + (size_t)q * 3072 + h * 128 + hi * 8;
#pragma unroll
          for (int d0 = 0; d0 < 8; ++d0) qr[d0] = *(const bf16x8*)(qp + d0 * 16); }
        f32x16 o[4] = {};
        float m = -1e30f, l = 0.f;
        const int tmax = w >> 1;
        MB_ISSUE(tq * 256, 0); VM_DRAIN();
        __syncthreads();
#pragma unroll 1
        for (int t = 0; t < 4; ++t) {
            const int b = t & 1;
            if (t + 1 < 4) MB_ISSUE(tq * 256 + (t + 1) * 64, b ^ 1);
            if (t <= tmax) attn_tile<8>(AL_K0 + b * AL_KB, vb0 + b * AL_VB, kb, qr, o, m, l, t == tmax, w * 32 + r32 - t * 64, alw, r32, hi);
            VM_DRAIN();
            __syncthreads();
        }
        const float lt = l + __shfl_xor(l, 32);
        const float2* mlp = ML + (size_t)(q * 8 + h) * 3;
        const float2 a0 = mlp[0], a1 = mlp[1], a2 = mlp[2];
        const float M = fmaxf(fmaxf(m, a0.x), fmaxf(a1.x, a2.x));
        const float wo = __builtin_amdgcn_exp2f(m - M);
        const float w0 = a0.y > 0.f ? a0.y * __builtin_amdgcn_exp2f(a0.x - M) : 0.f;
        const float w1 = a1.y > 0.f ? a1.y * __builtin_amdgcn_exp2f(a1.x - M) : 0.f;
        const float w2 = a2.y > 0.f ? a2.y * __builtin_amdgcn_exp2f(a2.x - M) : 0.f;
        const float inv = __builtin_amdgcn_rcpf(lt * wo + w0 + w1 + w2);
        if (hi == 0) { alw[r32] = wo * inv; alw[32 + r32] = w0 * inv; alw[64 + r32] = w1 * inv; alw[96 + r32] = w2 * inv; }
        asm volatile("s_waitcnt lgkmcnt(0)" ::: "memory");
        float* ob = (float*)g_lds + w * (32 * 68);
        const int rr = lane >> 1, cs = (lane & 1) * 32;
        const float c1 = alw[32 + rr], c2 = alw[64 + rr], c3 = alw[96 + rr];
        bf16_t* Ow = QKV + (size_t)(tq * 256 + w * 32 + rr) * 3072 + h * 128 + cs;
        const bf16_t* pp = PART + ((size_t)(tq * 256 + w * 32 + rr) * 24 + h) * 128 + cs;
#pragma unroll
        for (int half = 0; half < 2; ++half) {
#pragma unroll
            for (int r = 0; r < 16; ++r) { const int orow = crow(r, hi); const float c0 = alw[orow];
                ob[orow * 68 + r32] = o[2 * half][r] * c0; ob[orow * 68 + 32 + r32] = o[2 * half + 1][r] * c0; }
            asm volatile("s_waitcnt lgkmcnt(0)" ::: "memory");
            bf16x8 s0[4], s1[4], s2[4];
#pragma unroll
            for (int i = 0; i < 4; ++i) { s0[i] = *(const bf16x8*)(pp + half * 64 + i * 8); s1[i] = *(const bf16x8*)(pp + 1024 + half * 64 + i * 8); s2[i] = *(const bf16x8*)(pp + 2048 + half * 64 + i * 8); }
#pragma unroll
            for (int i = 0; i < 4; ++i) {
                const f32x4 a = *(const f32x4*)(ob + rr * 68 + cs + i * 8), bq = *(const f32x4*)(ob + rr * 68 + cs + i * 8 + 4);
                float v[8] = {a[0], a[1], a[2], a[3], bq[0], bq[1], bq[2], bq[3]};
#pragma unroll
                for (int j = 0; j < 8; ++j) {
                    v[j] += (c1 > 0.f) ? c1 * bf2f((unsigned short)s0[i][j]) : 0.f;
                    v[j] += (c2 > 0.f) ? c2 * bf2f((unsigned short)s1[i][j]) : 0.f;
                    v[j] += (c3 > 0.f) ? c3 * bf2f((unsigned short)s2[i][j]) : 0.f;
                }
                u32x4 wv = {cvtpk(v[0], v[1]), cvtpk(v[2], v[3]), cvtpk(v[4], v[5]), cvtpk(v[6], v[7])};
                *(u32x4*)(Ow + half * 64 + i * 8) = wv;
            }
            asm volatile("s_waitcnt lgkmcnt(0)" ::: "memory");
        }
        __syncthreads();
    }
}

#define XB_TMO      128
#define XB_XCNT(j)  (256  + 64 * (j))
#define XB_XSUB(j)  (1280 + 64 * (j))
#define XB_XGEN(j)  (2304 + 64 * (j))
#define XB_TOP      3328
#define XB_TOPGEN   3392
#define XB_SPIN_CAP (1u << 18)
DI unsigned xb_ld(unsigned* p)              { return __hip_atomic_load(p, __ATOMIC_RELAXED, __HIP_MEMORY_SCOPE_AGENT); }
DI unsigned xb_add(unsigned* p, unsigned v) { return __hip_atomic_fetch_add(p, v, __ATOMIC_RELAXED, __HIP_MEMORY_SCOPE_AGENT); }
DI unsigned xb_xcc_id() { return (unsigned)__builtin_amdgcn_s_getreg((3 << 11) | 20) & 0xFu; }
#define XB_SPIN(cond, bar) do { unsigned _sp = 0; while (cond) { __builtin_amdgcn_s_sleep(1); \
    if ((++_sp & 255u) == 0u) { if (xb_ld(&(bar)[XB_TMO])) break; if (_sp > XB_SPIN_CAP) { atomicAdd(&(bar)[XB_TMO], 1u); break; } } } } while (0)
struct XcdBarrier { unsigned* bar; unsigned x; volatile LAS unsigned* st; };
DI XcdBarrier xcd_barrier_post(unsigned* bar, volatile LAS unsigned* st) {
    XcdBarrier b; b.bar = bar; b.x = xb_xcc_id(); b.st = st;
    if (threadIdx.x == 0) (void)xb_add(&bar[XB_XCNT(b.x)], 1u);
    return b;
}
DI void xcd_barrier_complete(unsigned* bar, unsigned x, unsigned& nloc, unsigned& nx) {
    const unsigned G = gridDim.x * gridDim.y * gridDim.z;
    unsigned sum, cnt, mine, sp = 0u;
    for (;;) {
        sum = 0u; cnt = 0u; mine = 0u;
#pragma unroll
        for (unsigned j = 0; j < 16; ++j) { const unsigned c = xb_ld(&bar[XB_XCNT(j)]); sum += c; cnt += (c > 0u) ? 1u : 0u; mine = (j == x) ? c : mine; }
        if (sum == G) break;
        __builtin_amdgcn_s_sleep(1);
        if ((++sp & 255u) == 0u) { if (xb_ld(&bar[XB_TMO])) break; if (sp > XB_SPIN_CAP) { atomicAdd(&bar[XB_TMO], 1u); break; } }
    }
    nloc = mine > 0u ? mine : 1u; nx = cnt > 0u ? cnt : 1u;
}
DI void xcd_barrier(const XcdBarrier& b) {
    asm volatile("s_waitcnt vmcnt(0)" ::: "memory");
    __syncthreads();
    if (threadIdx.x == 0) {
        unsigned* bar = b.bar;
        __builtin_amdgcn_s_waitcnt(0);
        unsigned nloc = b.st[0], nx = b.st[1];
        if (nloc == 0u) { xcd_barrier_complete(bar, b.x, nloc, nx); b.st[0] = nloc; b.st[1] = nx; }
        const unsigned old = xb_add(&bar[XB_XSUB(b.x)], 1u);
        const unsigned gen = old / nloc;
        if (old + 1u == (gen + 1u) * nloc) {
            __builtin_amdgcn_fence(__ATOMIC_RELEASE, "agent");
            asm volatile("s_waitcnt vmcnt(0)" ::: "memory");
            const unsigned og = xb_add(&bar[XB_TOP], 1u);
            const unsigned tg = og / nx;
            if (og + 1u == (tg + 1u) * nx) xb_add(&bar[XB_TOPGEN], 1u);
            else XB_SPIN(xb_ld(&bar[XB_TOPGEN]) == tg, bar);
            __builtin_amdgcn_fence(__ATOMIC_ACQUIRE, "agent");
            xb_add(&bar[XB_XGEN(b.x)], 1u);
            asm volatile("s_waitcnt vmcnt(0)" ::: "memory");
        } else {
            XB_SPIN(xb_ld(&bar[XB_XGEN(b.x)]) == gen, bar);
            __builtin_amdgcn_fence(__ATOMIC_ACQUIRE, "agent");
            asm volatile("s_waitcnt vmcnt(0)" ::: "memory");
        }
    }
    __syncthreads();
}

constexpr int NPHASE = 19;
__global__ void __launch_bounds__(NTHR) fwd_megakernel(Params P) {
    unsigned char* ws = P.ws;
    const float* cosM = (const float*)(ws + WS_COSM); const float* sinM = (const float*)(ws + WS_SINM);
    const float* cosB = (const float*)(ws + WS_COSB); const float* sinB = (const float*)(ws + WS_SINB);
    bf16_t* XB = (bf16_t*)(ws + WS_XB);
    float* XF = P.out;
    const int lo = P.ph_lo, hi = P.ph_hi;
#define IN(k) (lo <= (k) && (k) < hi)
    volatile LAS unsigned* xst = (volatile LAS unsigned*)((LAS unsigned char*)g_lds + 131072 + 4096);
    if (threadIdx.x < 2) xst[threadIdx.x] = 0u;
    __syncthreads();
    XcdBarrier xbar; xbar.bar = (unsigned*)(ws + WS_CTL) + 4096; xbar.x = 0; xbar.st = xst;
    if (hi - lo > 1) xbar = xcd_barrier_post((unsigned*)(ws + WS_CTL) + 4096, xst);
    if (lo < 0) cg::this_grid().sync();
#define SEAM(k) do { if (IN(k) && IN((k) + 1)) xcd_barrier(xbar); } while (0)
    if (IN(0)) prep_phase(P);
    SEAM(0);
    if (IN(1)) { EpiLat e{(bf16_t*)(ws + WS_LAT), (bf16_t*)(ws + WS_KR), cosM, sinM};
        gemm_phase(XB, 1024, (const bf16_t*)(ws + WS_W0_DQKV), 1024, 64, 3, e); }
    SEAM(1);
    if (IN(2)) {
        { EpiQ e{(const bf16_t*)(ws + WS_LAT), (bf16_t*)(ws + WS_Q), cosM, sinM};
          gemm_phase((const bf16_t*)(ws + WS_LAT), 640, (const bf16_t*)(ws + WS_W0_UQ), 384, 64, 6, e); }
        { EpiKV e{(const bf16_t*)(ws + WS_LAT) + 384, (bf16_t*)(ws + WS_KV)};
          gemm_phase((const bf16_t*)(ws + WS_LAT) + 384, 640, (const bf16_t*)(ws + WS_W0_UKV), 256, 64, 8, e, 128); }
    }
    SEAM(2);
    if (IN(3)) mla_attn_phase(P);
    SEAM(3);
    if (IN(4)) { EpiRes e{P.in[0], (float*)(ws + WS_Y)};
        gemm_phase((const bf16_t*)(ws + WS_AO), 1024, (const bf16_t*)(ws + WS_W0_O), 1024, 64, 4, e); }
    SEAM(4);
    if (IN(5)) ln_phase((const float*)(ws + WS_Y), P.in[11], P.in[12], XF, XB);
    SEAM(5);
    if (IN(6)) { EpiSwiglu e{(bf16_t*)(ws + WS_H)};
        gemm_phase(XB, 1024, (const bf16_t*)(ws + WS_W0_IN), 1024, 64, 22, e); }
    SEAM(6);
    if (IN(7)) { EpiRes e{XF, (float*)(ws + WS_Y)};
        gemm_phase((const bf16_t*)(ws + WS_H), DFF, (const bf16_t*)(ws + WS_W0_OUT), DFF, 64, 4, e); }
    SEAM(7);
    if (IN(8)) ln_phase((const float*)(ws + WS_Y), P.in[13], P.in[14], XF, XB);
    SEAM(8);
    if (IN(9)) { EpiMobaQKV e{(bf16_t*)(ws + WS_QKV), cosB, sinB};
        gemm_phase(XB, 1024, (const bf16_t*)(ws + WS_W1_QKV), 1024, 64, 12, e); }
    SEAM(9);
    if (IN(10)) moba_kmean_phase(P);
    SEAM(10);
    if (IN(11)) moba_gate_phase(P);
    SEAM(11);
    if (IN(12)) moba_sel_phase(P);
    SEAM(12);
    if (IN(13)) moba_own_phase(P);
    SEAM(13);
    if (IN(14)) { EpiRes e{XF, (float*)(ws + WS_Y1)};
        gemm_phase((const bf16_t*)(ws + WS_QKV), 3072, (const bf16_t*)(ws + WS_W1_O), 1024, 64, 4, e); }
    SEAM(14);
    if (IN(15)) ln_phase((const float*)(ws + WS_Y1), P.in[11] + DM, P.in[12] + DM, XF, XB);
    SEAM(15);
    if (IN(16)) { EpiSwiglu e{(bf16_t*)(ws + WS_H)};
        gemm_phase(XB, 1024, (const bf16_t*)(ws + WS_W1_IN), 1024, 64, 22, e); }
    SEAM(16);
    if (IN(17)) { EpiRes e{XF, (float*)(ws + WS_Y)};
        gemm_phase((const bf16_t*)(ws + WS_H), DFF, (const bf16_t*)(ws + WS_W1_OUT), DFF, 64, 4, e); }
    SEAM(17);
    if (IN(18)) ln_phase((const float*)(ws + WS_Y), P.in[13] + DM, P.in[14] + DM, XF, nullptr);
#undef IN
#undef SEAM
}

extern "C" void kernel_launch(void* const* d_in, const int* in_sizes, int n_in, void* d_out, int out_size, void* d_ws, size_t ws_size, hipStream_t stream) {
    static int grid = 0;
    if (grid == 0) {
        if (n_in != 15 || out_size != S * DM || ws_size < WS_END) { fprintf(stderr, "kernel_launch: unexpected shapes (n_in %d out %d ws %zu)\n", n_in, out_size, ws_size); grid = -1; return; }
        int dev = 0, cus = 0, per_cu = 0;
        (void)hipGetDevice(&dev);
        (void)hipDeviceGetAttribute(&cus, hipDeviceAttributeMultiprocessorCount, dev);
        (void)hipFuncSetAttribute((const void*)fwd_megakernel, hipFuncAttributeMaxDynamicSharedMemorySize, LDS_BYTES);
        (void)hipOccupancyMaxActiveBlocksPerMultiprocessor(&per_cu, (const void*)fwd_megakernel, NTHR, LDS_BYTES);
        if (per_cu < 1) per_cu = 1;
        grid = cus * per_cu;
        if (grid <= 0) grid = 256;
    }
    if (grid < 0) return;
    (void)hipMemsetAsync((char*)d_ws + WS_CTL, 0, 1 * MiB, stream);
    Params p{};
    for (int i = 0; i < 15; ++i) p.in[i] = (const float*)d_in[i];
    p.out = (float*)d_out; p.ws = (unsigned char*)d_ws;
#if MK_MULTI
    for (int ph = 0; ph < NPHASE; ++ph) {
        p.ph_lo = ph; p.ph_hi = ph + 1;
        for (int rep = 0; rep < (((PROBE_MASK >> ph) & 1u) ? 2 : 1); ++rep)
            hipLaunchKernelGGL(fwd_megakernel, dim3(grid), dim3(NTHR), LDS_BYTES, stream, p);
    }
#else
    p.ph_lo = 0; p.ph_hi = NPHASE;
    void* args[] = {&p};
    hipError_t e = hipLaunchCooperativeKernel((const void*)fwd_megakernel, dim3(grid), dim3(NTHR), args, LDS_BYTES, stream);
    if (e != hipSuccess) fprintf(stderr, "cooperative launch failed: %s (grid %d)\n", hipGetErrorString(e), grid);
#endif
}
```

```cpp
#include <hip/hip_runtime.h>
#include <hip/hip_cooperative_groups.h>
#include <cstdint>
#include <cstdio>
namespace cg = cooperative_groups;

#ifndef MK_MULTI
#define MK_MULTI 0
#endif
#define PROBE_MASK 0u

#define DI __device__ __forceinline__
typedef unsigned short bf16_t;
typedef short bf16x8 __attribute__((ext_vector_type(8)));
typedef short s16x4 __attribute__((ext_vector_type(4)));
typedef float f32x4 __attribute__((ext_vector_type(4)));
typedef float f32x16 __attribute__((ext_vector_type(16)));
typedef unsigned u32x4 __attribute__((ext_vector_type(4)));
typedef unsigned u32x2 __attribute__((ext_vector_type(2)));

constexpr int S = 16384, DM = 1024, DFF = 2816;
constexpr int NTHR = 512;
constexpr size_t MiB = 1u << 20;
constexpr size_t WS_CTL = 0;
constexpr size_t WS_COSM = 1 * MiB, WS_SINM = 3 * MiB;
constexpr size_t WS_COSB = 5 * MiB, WS_SINB = 6 * MiB;
constexpr size_t WS_KMH = 7 * MiB, WS_KML = 7 * MiB + 131072;
constexpr size_t WS_W1_QKV = 8 * MiB, WS_W1_O = 14 * MiB, WS_W1_IN = 16 * MiB, WS_W1_OUT = 27 * MiB;
constexpr size_t WS_W0_DQKV = 33 * MiB, WS_W0_UQ = 35 * MiB, WS_W0_UKV = 37 * MiB, WS_W0_O = 38 * MiB, WS_W0_IN = 40 * MiB, WS_W0_OUT = 51 * MiB;
constexpr size_t WS_XB = 57 * MiB;
constexpr size_t WS_R = 89 * MiB;
constexpr size_t WS_AO = WS_R, WS_LAT = WS_R + 32 * MiB, WS_KR = WS_R + 52 * MiB, WS_Q = WS_R + 54 * MiB, WS_KV = WS_R + 102 * MiB;
constexpr size_t WS_Y = WS_R + 102 * MiB;
constexpr size_t WS_H = WS_R;
constexpr size_t WS_ML = 33 * MiB;
constexpr size_t WS_LIST = 36 * MiB;
constexpr size_t WS_PART = 57 * MiB;
constexpr size_t WS_QKV = 153 * MiB;
constexpr size_t WS_Y1 = 89 * MiB;
constexpr size_t WS_END = 256 * MiB;
constexpr int CTL_CNT = 16384;

constexpr int LDS_BYTES = 131072 + 8192;
extern __shared__ __attribute__((aligned(16))) unsigned char g_lds[];

struct Params { const float* in[15]; float* out; unsigned char* ws; int ph_lo, ph_hi; };

DI unsigned cvtpk(float lo, float hi) { unsigned r; asm("v_cvt_pk_bf16_f32 %0, %1, %2" : "=v"(r) : "v"(lo), "v"(hi)); return r; }
DI float bf2f(unsigned short v) { return __uint_as_float((unsigned)v << 16); }
DI int crow(int r, int hi) { return (r & 3) + 8 * (r >> 2) + 4 * hi; }
DI float wave_sum(float v) {
#pragma unroll
    for (int o = 1; o < 64; o <<= 1) v += __shfl_xor(v, o);
    return v;
}

__device__ const double kInvFreq[32] = {1.0, 0.6636012376960885, 0.44036660267178046, 0.2922278225730151, 0.19392274474868576, 0.12868737343265052, 0.08539710028576561, 0.05666962144529105, 0.03760603093086393, 0.024955408670558694, 0.016560440080994446, 0.010989528534539826, 0.007292664737217109, 0.004839421345719893, 0.003211445994752591, 0.0021311195369119653, 0.001414213562373095, 0.0009384738703573802, 0.000622772421914596, 0.0004132725499855165, 0.0002742481756762073, 0.00018199142881462546, 0.00012076973741146504, 8.01429472224798e-05, 5.318295896944988e-05, 3.529227739646723e-05, 2.341999896140934e-05, 1.5541540297632344e-05, 1.031338537721246e-05, 6.8439753011549275e-06, 4.5416704806078695e-06, 3.013858152139171e-06};

DI int srcmap(int code, int n) {
    switch (code) {
        case 1: { if (n < 640) return n; if (n < 704) { int j = n - 640; return 640 + (j >> 1) + 32 * (j & 1); } return -1; }
        case 2: { int h = n / 192, c = n - h * 192; if (c < 128) return n; int j = c - 128; return h * 192 + 128 + (j >> 1) + 32 * (j & 1); }
        case 3: { if (n >= 2048) return n; int c = n & 127; if (c >= 32) return n; return (n & ~127) + (c >> 1) + 16 * (c & 1); }
        case 4: { int q = n >> 5, t = (n >> 4) & 1, i = n & 15; return t * DFF + 16 * q + i; }
        default: return n;
    }
}
DI void wtrans(const float* __restrict__ W, int K, int N, bf16_t* __restrict__ Wt, int Np, int code, const float* __restrict__ kscale) {
    float* tile = (float*)g_lds;
    const int tid = threadIdx.x;
    const int tk = K / 64, tn = Np / 64, nt = tk * tn;
    for (int t = blockIdx.x; t < nt; t += gridDim.x) {
        const int n0 = (t / tk) * 64, k0 = (t % tk) * 64;
        __syncthreads();
        {
            const int nn = tid & 63; const int src = srcmap(code, n0 + nn);
#pragma unroll
            for (int i = 0; i < 8; ++i) {
                const int kk = (tid >> 6) + 8 * i;
                float v = 0.f;
                if (src >= 0) { v = W[(size_t)(k0 + kk) * N + src]; if (kscale) v *= kscale[k0 + kk]; }
                tile[kk * 65 + nn] = v;
            }
        }
        __syncthreads();
        {
            const int kk = (tid & 31) * 2;
#pragma unroll
            for (int i = 0; i < 4; ++i) {
                const int nn = (tid >> 5) + 16 * i;
                *(unsigned*)(Wt + (size_t)(n0 + nn) * K + k0 + kk) = cvtpk(tile[kk * 65 + nn], tile[(kk + 1) * 65 + nn]);
            }
        }
    }
}

DI void prep_phase(const Params& P) {
    unsigned char* ws = P.ws;
    const int tid = threadIdx.x;
    const size_t gt = (size_t)blockIdx.x * NTHR + tid, gs = (size_t)gridDim.x * NTHR;
    {
        const float* x = P.in[0]; bf16_t* xb = (bf16_t*)(ws + WS_XB);
        for (size_t i = gt; i < (size_t)S * DM / 8; i += gs) {
            const f32x4 a = *(const f32x4*)(x + i * 8), b = *(const f32x4*)(x + i * 8 + 4);
            u32x4 w = {cvtpk(a[0], a[1]), cvtpk(a[2], a[3]), cvtpk(b[0], b[1]), cvtpk(b[2], b[3])};
            *(u32x4*)(xb + i * 8) = w;
        }
    }
    {
        float* cm = (float*)(ws + WS_COSM); float* sm = (float*)(ws + WS_SINM); float* cb = (float*)(ws + WS_COSB); float* sb = (float*)(ws + WS_SINB);
        for (size_t i = gt; i < (size_t)S * 32; i += gs) {
            const int pos = (int)(i >> 5), f = (int)(i & 31);
            const double rev = (double)pos * kInvFreq[f] * 0.15915494309189535;
            const float fr = (float)(rev - floor(rev));
            const float c = __builtin_amdgcn_cosf(fr), s = __builtin_amdgcn_sinf(fr);
            cm[i] = c; sm[i] = s;
            if ((f & 1) == 0) { cb[pos * 16 + (f >> 1)] = c; sb[pos * 16 + (f >> 1)] = s; }
        }
    }
    wtrans(P.in[1], 1024, 704, (bf16_t*)(ws + WS_W0_DQKV), 768, 1, nullptr);
    wtrans(P.in[3], 384, 1536, (bf16_t*)(ws + WS_W0_UQ), 1536, 2, P.in[2]);
    wtrans(P.in[5], 256, 2048, (bf16_t*)(ws + WS_W0_UKV), 2048, 0, P.in[4]);
    wtrans(P.in[6], 1024, 1024, (bf16_t*)(ws + WS_W0_O), 1024, 0, nullptr);
    wtrans(P.in[7], 1024, 3072, (bf16_t*)(ws + WS_W1_QKV), 3072, 3, nullptr);
    wtrans(P.in[8], 1024, 1024, (bf16_t*)(ws + WS_W1_O), 1024, 0, nullptr);
    wtrans(P.in[9], 1024, 2 * DFF, (bf16_t*)(ws + WS_W0_IN), 2 * DFF, 4, nullptr);
    wtrans(P.in[9] + (size_t)1024 * 2 * DFF, 1024, 2 * DFF, (bf16_t*)(ws + WS_W1_IN), 2 * DFF, 4, nullptr);
    wtrans(P.in[10], DFF, 1024, (bf16_t*)(ws + WS_W0_OUT), 1024, 0, nullptr);
    wtrans(P.in[10] + (size_t)DFF * 1024, DFF, 1024, (bf16_t*)(ws + WS_W1_OUT), 1024, 0, nullptr);
}

DI void ln_phase(const float* __restrict__ Y, const float* __restrict__ g, const float* __restrict__ b, float* __restrict__ XF, bf16_t* __restrict__ XBo) {
    const int tid = threadIdx.x, wave = tid >> 6, lane = tid & 63;
    for (int row = blockIdx.x * 8 + wave; row < S; row += gridDim.x * 8) {
        const f32x4* yr = (const f32x4*)(Y + (size_t)row * DM);
        f32x4 v[4];
#pragma unroll
        for (int i = 0; i < 4; ++i) v[i] = yr[lane + 64 * i];
        float s = 0.f;
#pragma unroll
        for (int i = 0; i < 4; ++i) s += (v[i][0] + v[i][1]) + (v[i][2] + v[i][3]);
        s = wave_sum(s);
        const float mean = s * (1.0f / DM);
        float q = 0.f;
#pragma unroll
        for (int i = 0; i < 4; ++i) { const f32x4 d = v[i] - mean; q += (d[0] * d[0] + d[1] * d[1]) + (d[2] * d[2] + d[3] * d[3]); }
        q = wave_sum(q);
        const float rstd = rsqrtf(q * (1.0f / DM) + 1e-5f);
#pragma unroll
        for (int i = 0; i < 4; ++i) {
            const int col = (lane + 64 * i) * 4;
            const f32x4 gg = *(const f32x4*)(g + col), bb = *(const f32x4*)(b + col);
            const f32x4 o = (v[i] - mean) * rstd * gg + bb;
            *(f32x4*)(XF + (size_t)row * DM + col) = o;
            if (XBo) { u32x2 w = {cvtpk(o[0], o[1]), cvtpk(o[2], o[3])}; *(u32x2*)(XBo + (size_t)row * DM + col) = w; }
        }
    }
}

constexpr int BM = 256, BK = 64, HALF = 128, HT = HALF * BK, NXCD = 8, WGM = 8;
DI int lds_byte(int r, int c) { int st = (r >> 4) * 2 + (c >> 5), rr = r & 15, cc = c & 31, ob = rr * 64 + cc * 2; return st * 1024 + (ob ^ (((ob >> 9) & 1) << 5)); }
DI void stage_rc(int b, int& R, int& C) { int st = b / 1024, sb = b % 1024, swz = sb ^ (((sb >> 9) & 1) << 5); R = (st >> 1) * 16 + swz / 64; C = (st & 1) * 32 + (swz % 64) / 2; }

#define LAS __attribute__((address_space(3)))
struct Unit { int pm, pn; };
DI bool unit_next(int i, int G, int c, int nM, int nN, Unit& u) {
    const int nwg = nM * nN;
    const long L = (long)i * G + c; if (L >= nwg) return false;
    int wgid = (int)L;
    { const int q = nwg / NXCD, r = nwg % NXCD, xcd = wgid % NXCD, off = wgid / NXCD; wgid = (xcd < r ? xcd * (q + 1) : r * (q + 1) + (xcd - r) * q) + off; }
    const int nig = WGM * nN, gid = wgid / nig, fm = gid * WGM, gsz = (nM - fm) < WGM ? (nM - fm) : WGM;
    u.pm = fm + ((wgid % nig) % gsz); u.pn = (wgid % nig) / gsz; return true;
}
template <class Epi>
DI void gemm_phase(const bf16_t* __restrict__ A, int lda, const bf16_t* __restrict__ Bt, int K, int nM, int nN, const Epi& E, int cshift = 0) {
    LAS unsigned char* lds = (LAS unsigned char*)g_lds;
    constexpr int HTB = HT * 2;
#define SA(b, h) (((b) * 2 + (h)) * HTB)
#define SB(b, h) ((4 + (b) * 2 + (h)) * HTB)
#define STAGE(bufoff, gbase, voff) do { _Pragma("unroll") for (int _i = 0; _i < 2; ++_i) \
        __builtin_amdgcn_global_load_lds((const unsigned*)((const char*)(gbase) + (voff)[_i]), (LAS unsigned*)(lds + (bufoff) + ldsw + _i * 8192), 16, 0, 0); } while (0)
#define LDA(dst, b, h) do { _Pragma("unroll") for (int m = 0; m < 4; ++m) _Pragma("unroll") for (int k = 0; k < 2; ++k) dst[m][k] = *(const LAS bf16x8*)(lds + SA(b, h) + aoff + m * 2048 + k * 1024); } while (0)
#define LDB(dst, b, h) do { _Pragma("unroll") for (int n = 0; n < 2; ++n) _Pragma("unroll") for (int k = 0; k < 2; ++k) dst[n][k] = *(const LAS bf16x8*)(lds + SB(b, h) + boff + n * 2048 + k * 1024); } while (0)
#define MMA(ai, bj, At_, Bt_) do { __builtin_amdgcn_s_setprio(1); \
    _Pragma("unroll") for (int m = 0; m < 4; ++m) _Pragma("unroll") for (int n = 0; n < 2; ++n) _Pragma("unroll") for (int k = 0; k < 2; ++k) \
      acc[ai][bj][m][n] = __builtin_amdgcn_mfma_f32_16x16x32_bf16(Bt_[n][k], At_[m][k], acc[ai][bj][m][n], 0, 0, 0); \
    __builtin_amdgcn_s_setprio(0); } while (0)
#define WAIT_V(n) asm volatile("s_waitcnt vmcnt(" #n ")" ::: "memory")
#define WAIT_L(n) asm volatile("s_waitcnt lgkmcnt(" #n ")" ::: "memory")
#define BAR __builtin_amdgcn_s_barrier()
#define SCHED __builtin_amdgcn_sched_barrier(0)
#define ACC_ZERO() do { _Pragma("unroll") for (int a_ = 0; a_ < 2; ++a_) _Pragma("unroll") for (int b_ = 0; b_ < 2; ++b_) _Pragma("unroll") for (int m_ = 0; m_ < 4; ++m_) \
    _Pragma("unroll") for (int n_ = 0; n_ < 2; ++n_) acc[a_][b_][m_][n_] = (f32x4){0.f, 0.f, 0.f, 0.f}; } while (0)
    __syncthreads();
    int tid = threadIdx.x; asm volatile("" : "+v"(tid));
    const int wid = __builtin_amdgcn_readfirstlane(tid >> 6), lane = tid & 63, wr = wid >> 2, wc = wid & 3, fr = lane & 15, fq = lane >> 4;
    const int G = gridDim.x, c = ((int)blockIdx.x + cshift) % G;
    unsigned voffA[2], voffB[2];
#pragma unroll
    for (int i = 0; i < 2; ++i) { int R, C; stage_rc(tid * 16 + i * 8192, R, C); voffA[i] = (unsigned)(R * lda + C) * 2u; voffB[i] = (unsigned)(R * K + C) * 2u; }
    const size_t kstep = (size_t)(BK * 2), hA = (size_t)HALF * lda * 2, hB = (size_t)HALF * K * 2;
    const unsigned ldsw = (unsigned)wid * 1024u;
    const int aoff = lds_byte(wr * 64 + fr, fq * 8), boff = lds_byte(wc * 32 + fr, fq * 8);
    const int nt = K / BK;
    Unit cur, nxt; int ui = 0;
    if (!unit_next(0, G, c, nM, nN, cur)) return;
    f32x4 acc[2][2][4][2];
    ACC_ZERO();
    bf16x8 At[4][2], B0[2][2], B1[2][2];
    const char* cA = (const char*)A + (size_t)cur.pm * 2 * hA; const char* cB = (const char*)Bt + (size_t)cur.pn * 2 * hB;
    STAGE(SB(0, 0), cB, voffB); STAGE(SA(0, 0), cA, voffA); STAGE(SB(0, 1), cB + hB, voffB); STAGE(SA(0, 1), cA + hA, voffA);
    if (wr == 1) BAR;
    WAIT_V(4); BAR;
    STAGE(SB(1, 0), cB + kstep, voffB); STAGE(SA(1, 0), cA + kstep, voffA); STAGE(SB(1, 1), cB + hB + kstep, voffB);
    WAIT_V(6); BAR;
    for (;;) {
        const bool has_next = unit_next(ui + 1, G, c, nM, nN, nxt);
        const char* nA = has_next ? (const char*)A + (size_t)nxt.pm * 2 * hA : cA; const char* nB = has_next ? (const char*)Bt + (size_t)nxt.pn * 2 * hB : cB;
#pragma unroll 1
        for (int t = 0; t < nt; t += 2) {
            const bool last = (t == nt - 2);
            const char* a1 = cA + (size_t)(t + 1) * kstep;
            const char* a2 = last ? nA : cA + (size_t)(t + 2) * kstep; const char* b2 = last ? nB : cB + (size_t)(t + 2) * kstep;
            const char* a3 = a2 + kstep; const char* b3 = b2 + kstep;
            LDB(B0, 0, 0); SCHED; LDA(At, 0, 0); STAGE(SA(1, 1), a1 + hA, voffA);
            WAIT_L(8); BAR; WAIT_L(0); MMA(0, 0, At, B0); BAR; SCHED;
            LDB(B1, 0, 1); STAGE(SB(0, 0), b2, voffB);
            BAR; WAIT_L(0); MMA(0, 1, At, B1); BAR;
            LDA(At, 0, 1); STAGE(SA(0, 0), a2, voffA);
            BAR; WAIT_L(0); MMA(1, 0, At, B0); BAR; SCHED;
            STAGE(SB(0, 1), b2 + hB, voffB);
            WAIT_V(6); BAR; MMA(1, 1, At, B1); BAR;
            LDB(B0, 1, 0); SCHED; LDA(At, 1, 0); STAGE(SA(0, 1), a2 + hA, voffA);
            WAIT_L(8); BAR; WAIT_L(0); MMA(0, 0, At, B0); BAR; SCHED;
            LDB(B1, 1, 1); STAGE(SB(1, 0), b3, voffB);
            BAR; WAIT_L(0); MMA(0, 1, At, B1); BAR;
            LDA(At, 1, 1); STAGE(SA(1, 0), a3, voffA);
            BAR; WAIT_L(0); MMA(1, 0, At, B0); BAR; SCHED;
            STAGE(SB(1, 1), b3 + hB, voffB);
            WAIT_V(6); BAR; MMA(1, 1, At, B1); BAR;
        }
        if (wr == 0) BAR;
        if (Epi::HAS_PRE) { E.pre(cur.pm); __syncthreads(); }
        { int t2 = threadIdx.x; asm volatile("" : "+v"(t2));
          const int w2 = t2 >> 6, l2 = t2 & 63;
          E(acc, cur.pm, cur.pn, w2 >> 2, w2 & 3, l2 & 15, l2 >> 4); }
        if (!has_next) break;
        ACC_ZERO();
        cur = nxt; cA = nA; cB = nB; ++ui;
        if (wr == 1) BAR;
    }
    WAIT_V(0);
    BAR;
#undef SA
#undef SB
#undef STAGE
#undef LDA
#undef LDB
#undef MMA
#undef ACC_ZERO
}

#define EPI_LOOP_BEGIN \
    _Pragma("unroll") for (int ai = 0; ai < 2; ++ai) _Pragma("unroll") for (int m = 0; m < 4; ++m) { \
        const int rl = ai * HALF + wr * 64 + m * 16 + fr; const int row = pm * BM + rl; (void)rl; \
        _Pragma("unroll") for (int bj = 0; bj < 2; ++bj) _Pragma("unroll") for (int n = 0; n < 2; ++n) { \
            const int col = pn * BM + bj * HALF + wc * 32 + n * 16 + fq * 4; f32x4 v = acc[ai][bj][m][n];
#define EPI_LOOP_END } }

DI void st_bf4(bf16_t* p, f32x4 v) { u32x2 w = {cvtpk(v[0], v[1]), cvtpk(v[2], v[3])}; *(u32x2*)p = w; }
DI f32x4 rope4(f32x4 v, const float* ct, const float* st) {
    const float c0 = ct[0], s0 = st[0], c1 = ct[1], s1 = st[1];
    return (f32x4){v[0] * c0 - v[1] * s0, v[1] * c0 + v[0] * s0, v[2] * c1 - v[3] * s1, v[3] * c1 + v[2] * s1};
}

struct EpiLat {
    bf16_t* LAT; bf16_t* KR; const float* cosM; const float* sinM; float* SSQP;
    static constexpr bool HAS_PRE = false;
    DI void pre(int) const {}
    DI void operator()(const f32x4 (&acc)[2][2][4][2], int pm, int pn, int wr, int wc, int fr, int fq) const {
        EPI_LOOP_BEGIN
            if (col < 640) st_bf4(LAT + (size_t)row * 640 + col, v);
            else if (col < 704) { const int i0 = (col - 640) >> 1; st_bf4(KR + (size_t)row * 64 + (col - 640), rope4(v, cosM + row * 32 + i0, sinM + row * 32 + i0)); }
        EPI_LOOP_END
#pragma unroll
        for (int ai = 0; ai < 2; ++ai)
#pragma unroll
            for (int m = 0; m < 4; ++m) {
                const int row = pm * BM + ai * HALF + wr * 64 + m * 16 + fr;
#pragma unroll
                for (int bj = 0; bj < 2; ++bj) {
                    const f32x4 a = acc[ai][bj][m][0], b = acc[ai][bj][m][1];
                    float s = (a[0] * a[0] + a[1] * a[1]) + (a[2] * a[2] + a[3] * a[3]) + (b[0] * b[0] + b[1] * b[1]) + (b[2] * b[2] + b[3] * b[3]);
                    s += __shfl_xor(s, 16); s += __shfl_xor(s, 32);
                    const int g = pn * 8 + bj * 4 + wc;
                    if (fq == 0 && g < 20) SSQP[(size_t)row * 24 + g] = s;
                }
            }
    }
};
constexpr float QSCALE_A = 0.10411754627697264f;
constexpr float QSCALE_B = 0.12751743082459868f;
template <int G0, int NG> DI void rs_pre(const float* SSQP, int pm) {
    float* rs = (float*)(g_lds + 131072);
    int tid = threadIdx.x; asm volatile("" : "+v"(tid));
    if (tid < 256) {
        const float* p = SSQP + (size_t)(pm * BM + tid) * 24 + G0;
        float ss = 0.f;
#pragma unroll
        for (int i = 0; i < NG / 4; ++i) { const f32x4 v = *(const f32x4*)(p + 4 * i); ss += (v[0] + v[1]) + (v[2] + v[3]); }
        rs[tid] = rsqrtf(ss * (1.0f / (NG * 32)) + 1e-6f);
    }
}
struct EpiQ {
    const float* SSQP; bf16_t* Q; const float* cosM; const float* sinM;
    static constexpr bool HAS_PRE = true;
    DI void pre(int pm) const { rs_pre<0, 12>(SSQP, pm); }
    DI void operator()(const f32x4 (&acc)[2][2][4][2], int pm, int pn, int wr, int wc, int fr, int fq) const {
        int fro = wr * 64 + fr; asm volatile("" : "+v"(fro));
        const float* rs = (const float*)(g_lds + 131072) + fro;
        EPI_LOOP_BEGIN
            v = v * (rs[ai * HALF + m * 16] * QSCALE_A);
            const int c = col % 192;
            if (c >= 128) { const int i0 = (c - 128) >> 1; v = rope4(v, cosM + row * 32 + i0, sinM + row * 32 + i0); }
            st_bf4(Q + (size_t)row * 1536 + col, v);
            if (bj == 1 && n == 1) __builtin_amdgcn_sched_barrier(0);
        EPI_LOOP_END
    }
};
struct EpiKV {
    const float* SSQP; bf16_t* KV;
    static constexpr bool HAS_PRE = true;
    DI void pre(int pm) const { rs_pre<12, 8>(SSQP, pm); }
    DI void operator()(const f32x4 (&acc)[2][2][4][2], int pm, int pn, int wr, int wc, int fr, int fq) const {
        int fro = wr * 64 + fr; asm volatile("" : "+v"(fro));
        const float* rs = (const float*)(g_lds + 131072) + fro;
        EPI_LOOP_BEGIN
            v = v * rs[ai * HALF + m * 16];
            st_bf4(KV + (size_t)row * 2048 + col, v);
            if (bj == 1 && n == 1) __builtin_amdgcn_sched_barrier(0);
        EPI_LOOP_END
    }
};
struct EpiRes {
    const float* R; float* Y;
    static constexpr bool HAS_PRE = false;
    DI void pre(int) const {}
    DI void operator()(const f32x4 (&acc)[2][2][4][2], int pm, int pn, int wr, int wc, int fr, int fq) const {
        EPI_LOOP_BEGIN
            const f32x4 r = *(const f32x4*)(R + (size_t)row * DM + col);
            *(f32x4*)(Y + (size_t)row * DM + col) = r * 1.4142135623730951f + v;
        EPI_LOOP_END
    }
};
struct EpiSwiglu {
    bf16_t* H;
    static constexpr bool HAS_PRE = false;
    DI void pre(int) const {}
    DI void operator()(const f32x4 (&acc)[2][2][4][2], int pm, int pn, int wr, int wc, int fr, int fq) const {
#pragma unroll
        for (int ai = 0; ai < 2; ++ai)
#pragma unroll
            for (int m = 0; m < 4; ++m) {
                const int row = pm * BM + ai * HALF + wr * 64 + m * 16 + fr;
#pragma unroll
                for (int bj = 0; bj < 2; ++bj) {
                    const f32x4 g = acc[ai][bj][m][0], u = acc[ai][bj][m][1];
                    f32x4 h;
#pragma unroll
                    for (int j = 0; j < 4; ++j) h[j] = g[j] * __builtin_amdgcn_rcpf(1.0f + __builtin_amdgcn_exp2f(-1.4426950408889634f * g[j])) * u[j];
                    st_bf4(H + (size_t)row * DFF + pn * 128 + bj * 64 + wc * 16 + fq * 4, h);
                }
            }
    }
};
struct EpiMobaQKV {
    bf16_t* QKV; const float* cosB; const float* sinB;
    static constexpr bool HAS_PRE = false;
    DI void pre(int) const {}
    DI void operator()(const f32x4 (&acc)[2][2][4][2], int pm, int pn, int wr, int wc, int fr, int fq) const {
        EPI_LOOP_BEGIN
            if (col < 2048) { const int c = col & 127; if (c < 32) { const int i0 = c >> 1; v = rope4(v, cosB + row * 16 + i0, sinB + row * 16 + i0); } }
            if (col < 1024) v = v * QSCALE_B;
            st_bf4(QKV + (size_t)row * 3072 + col, v);
        EPI_LOOP_END
    }
};

constexpr int AL_K0 = 0, AL_KB = 24576, AL_V0 = 49152, AL_VB = 16384, AL_W = 81920;
#define MFMA32(a, b, c) __builtin_amdgcn_mfma_f32_32x32x16_bf16((a), (b), (c), 0, 0, 0)
DI void dma16(const void* g, unsigned ldsoff) {
    __builtin_amdgcn_global_load_lds((const unsigned*)g, (LAS unsigned*)((LAS unsigned char*)g_lds + ldsoff), 16, 0, 0);
}
DI bf16x8 pack8(const f32x16& x, int s) {
    u32x4 w = {cvtpk(x[8 * s], x[8 * s + 1]), cvtpk(x[8 * s + 2], x[8 * s + 3]), cvtpk(x[8 * s + 4], x[8 * s + 5]), cvtpk(x[8 * s + 6], x[8 * s + 7])};
    return __builtin_bit_cast(bf16x8, w);
}
template <int ND> struct KBase { int b[ND == 12 ? 4 : 8]; };
template <int ND> DI KBase<ND> make_kbase(int r32, int hi) {
    KBase<ND> k;
    if constexpr (ND == 12) {
#pragma unroll
        for (int dd = 0; dd < 4; ++dd) k.b[dd] = r32 * 384 + (((dd * 2 + hi) ^ ((r32 >> 1) & 7)) << 4);
    } else {
#pragma unroll
        for (int dd = 0; dd < 8; ++dd) k.b[dd] = r32 * 256 + (((dd * 2 + hi) ^ (r32 & 15)) << 4);
    }
    return k;
}
DI unsigned v_lane_base(int lane) {
    const int i16 = lane & 15, g = lane >> 4, rowq = i16 >> 2, pp = i16 & 3, colblk = g & 1, hi = g >> 1;
    return (unsigned)(hi * 1024 + rowq * 64 + colblk * 32 + pp * 8);
}
template <int ND>
DI void attn_tile(int kbuf_off, unsigned vb, const KBase<ND>& kb, const bf16x8* qr, f32x16 (&o)[4], float& m, float& l, bool domask, int qrel, float* alw, int r32, int hi) {
    f32x16 p0 = {}, p1 = {};
    constexpr int RS = (ND == 12) ? 384 : 256;
    const unsigned char* kbuf = g_lds + kbuf_off;
#pragma unroll
    for (int dg = 0; dg < ND / 2; ++dg) {
        bf16x8 b0[2], b1[2];
#pragma unroll
        for (int i = 0; i < 2; ++i) {
            const int d0 = dg * 2 + i;
            const unsigned char* a = (ND == 12) ? (kbuf + kb.b[d0 & 3] + (d0 >> 2) * 128) : (kbuf + kb.b[d0 & 7]);
            b0[i] = *(const bf16x8*)a; b1[i] = *(const bf16x8*)(a + 32 * RS);
        }
#pragma unroll
        for (int i = 0; i < 2; ++i) { p0 = MFMA32(b0[i], qr[dg * 2 + i], p0); p1 = MFMA32(b1[i], qr[dg * 2 + i], p1); }
        __builtin_amdgcn_sched_barrier(0);
    }
    if (domask) {
        const float NEG = -__builtin_inff();
#pragma unroll
        for (int r = 0; r < 16; ++r) { const int k0 = (r & 3) + 8 * (r >> 2) + 4 * hi; if (k0 > qrel) p0[r] = NEG; if (k0 + 32 > qrel) p1[r] = NEG; }
    }
    float mx = p0[0];
#pragma unroll
    for (int r = 1; r < 16; ++r) mx = fmaxf(mx, p0[r]);
#pragma unroll
    for (int r = 0; r < 16; ++r) mx = fmaxf(mx, p1[r]);
    mx = fmaxf(mx, __shfl_xor(mx, 32));
    if (!__all(mx - m <= 11.0f)) {
        const float mn = fmaxf(m, mx);
        const float alpha = __builtin_amdgcn_exp2f(m - mn);
        m = mn; l *= alpha;
        if (hi == 0) alw[r32] = alpha;
        asm volatile("s_waitcnt lgkmcnt(0)" ::: "memory");
#pragma unroll
        for (int r = 0; r < 16; ++r) { const float a = alw[crow(r, hi)];
#pragma unroll
            for (int d0 = 0; d0 < 4; ++d0) o[d0][r] *= a; }
        asm volatile("s_waitcnt lgkmcnt(0)" ::: "memory");
    }
    float ps = 0.f;
#pragma unroll
    for (int r = 0; r < 16; ++r) { p0[r] = __builtin_amdgcn_exp2f(p0[r] - m); ps += p0[r]; }
#pragma unroll
    for (int r = 0; r < 16; ++r) { p1[r] = __builtin_amdgcn_exp2f(p1[r] - m); ps += p1[r]; }
    l += ps;
    const bf16x8 pa0 = pack8(p0, 0), pa1 = pack8(p0, 1), pa2 = pack8(p1, 0), pa3 = pack8(p1, 1);
#define TRRD(dst, off) asm volatile("ds_read_b64_tr_b16 %0, %1 offset:%2" : "=&v"(dst) : "v"(vb), "i"(off) : "memory")
#define PV_D0(d0) do { s16x4 l0, l1, h0, h1; constexpr int b_ = (d0) * 256; \
        TRRD(l0, b_); TRRD(h0, b_ + 2048); TRRD(l1, b_ + 4096); TRRD(h1, b_ + 6144); \
        asm volatile("s_waitcnt lgkmcnt(0)" ::: "memory"); __builtin_amdgcn_sched_barrier(0); \
        o[d0] = MFMA32(pa0, ((bf16x8){l0[0], l0[1], l0[2], l0[3], h0[0], h0[1], h0[2], h0[3]}), o[d0]); \
        o[d0] = MFMA32(pa1, ((bf16x8){l1[0], l1[1], l1[2], l1[3], h1[0], h1[1], h1[2], h1[3]}), o[d0]); \
        TRRD(l0, b_ + 8192); TRRD(h0, b_ + 10240); TRRD(l1, b_ + 12288); TRRD(h1, b_ + 14336); \
        asm volatile("s_waitcnt lgkmcnt(0)" ::: "memory"); __builtin_amdgcn_sched_barrier(0); \
        o[d0] = MFMA32(pa2, ((bf16x8){l0[0], l0[1], l0[2], l0[3], h0[0], h0[1], h0[2], h0[3]}), o[d0]); \
        o[d0] = MFMA32(pa3, ((bf16x8){l1[0], l1[1], l1[2], l1[3], h1[0], h1[1], h1[2], h1[3]}), o[d0]); } while (0)
    PV_D0(0); PV_D0(1); PV_D0(2); PV_D0(3);
#undef PV_D0
#undef TRRD
}
#define VM_DRAIN() asm volatile("s_waitcnt vmcnt(0)" ::: "memory")

DI void mla_block(const bf16_t* __restrict__ Q, const bf16_t* __restrict__ KV, const bf16_t* __restrict__ KR, bf16_t* __restrict__ AO, int h, int qb) {
    int tid = threadIdx.x; asm volatile("" : "+v"(tid));
    const int w = __builtin_amdgcn_readfirstlane(tid >> 6), lane = tid & 63, r32 = lane & 31, hi = lane >> 5;
    float* alw = (float*)(g_lds + AL_W + w * 512);
    const int NT = 4 * qb + 4, tmax = 4 * qb + (w >> 1);
    const int row = qb * 256 + w * 32 + r32;
    bf16x8 qr[12];
    { const bf16_t* qp = Q + (size_t)row * 1536 + h * 192 + hi * 8;
#pragma unroll
      for (int d0 = 0; d0 < 12; ++d0) qr[d0] = *(const bf16x8*)(qp + d0 * 16); }
    int ksrc[3], vsrc[2];
#pragma unroll
    for (int i = 0; i < 3; ++i) { const int b = (i * 8 + w) * 1024 + lane * 16, kr = b / 384, pc = (b - kr * 384) >> 4, c = pc ^ ((kr >> 1) & 7);
        ksrc[i] = (c < 16) ? (kr * 2048 + h * 256 + c * 8) : -(kr * 64 + (c - 16) * 8) - 1; }
#pragma unroll
    for (int i = 0; i < 2; ++i) { const int key = (i * 8 + w) * 4 + ((lane >> 2) & 3), col = (lane >> 4) * 32 + (lane & 3) * 8; vsrc[i] = key * 2048 + h * 256 + 128 + col; }
#define MLA_ISSUE(t_, b_) do { const bf16_t* kvb_ = KV + (size_t)(t_) * 64 * 2048; const bf16_t* krb_ = KR + (size_t)(t_) * 64 * 64; \
    _Pragma("unroll") for (int i = 0; i < 3; ++i) dma16((ksrc[i] >= 0) ? (const void*)(kvb_ + ksrc[i]) : (const void*)(krb_ + (-ksrc[i] - 1)), AL_K0 + (b_) * AL_KB + (i * 8 + w) * 1024); \
    _Pragma("unroll") for (int i = 0; i < 2; ++i) dma16(kvb_ + vsrc[i], AL_V0 + (b_) * AL_VB + (i * 8 + w) * 1024); } while (0)
    f32x16 o[4] = {};
    float m = -1e30f, l = 0.f;
    const unsigned vb0 = (unsigned)(uintptr_t)(g_lds + AL_V0) + v_lane_base(lane);
    const KBase<12> kb = make_kbase<12>(r32, hi);
    MLA_ISSUE(0, 0); VM_DRAIN();
    __syncthreads();
#pragma unroll 1
    for (int t = 0; t < NT; ++t) {
        const int b = t & 1;
        if (t + 1 < NT) MLA_ISSUE(t + 1, b ^ 1);
        if (t <= tmax) attn_tile<12>(AL_K0 + b * AL_KB, vb0 + b * AL_VB, kb, qr, o, m, l, t == tmax, row - t * 64, alw, r32, hi);
        VM_DRAIN();
        __syncthreads();
    }
#undef MLA_ISSUE
    const float lt = l + __shfl_xor(l, 32);
    if (hi == 0) alw[r32] = __builtin_amdgcn_rcpf(lt);
    asm volatile("s_waitcnt lgkmcnt(0)" ::: "memory");
    bf16_t* Ow = AO + (size_t)(qb * 256 + w * 32) * 1024 + h * 128;
#pragma unroll
    for (int r = 0; r < 16; ++r) { const int orow = crow(r, hi); const float inv = alw[orow];
#pragma unroll
        for (int d0 = 0; d0 < 4; ++d0) { const float v = o[d0][r] * inv; const float vn = __shfl_xor(v, 1);
            if ((r32 & 1) == 0) *(unsigned*)(Ow + (size_t)orow * 1024 + d0 * 32 + r32) = cvtpk(v, vn); } }
    asm volatile("s_waitcnt lgkmcnt(0)" ::: "memory");
}
DI void mla_attn_phase(const Params& P) {
    const bf16_t* Q = (const bf16_t*)(P.ws + WS_Q); const bf16_t* KV = (const bf16_t*)(P.ws + WS_KV); const bf16_t* KR = (const bf16_t*)(P.ws + WS_KR);
    bf16_t* AO = (bf16_t*)(P.ws + WS_AO);
    for (int item = blockIdx.x; item < 256; item += gridDim.x) {
        const int h = item & 7, p = item >> 3;
#pragma unroll 1
        for (int sub = 0; sub < 2; ++sub) mla_block(Q, KV, KR, AO, h, sub ? p : 63 - p);
    }
}

DI void moba_kmean_phase(const Params& P) {
    const bf16_t* QKV = (const bf16_t*)(P.ws + WS_QKV); bf16_t* KMH = (bf16_t*)(P.ws + WS_KMH); bf16_t* KML = (bf16_t*)(P.ws + WS_KML);
    float* red = (float*)g_lds;
    const int tid = threadIdx.x, d = tid & 127, part = tid >> 7;
    for (int item = blockIdx.x; item < 512; item += gridDim.x) {
        const int h = item >> 6, j = item & 63;
        const bf16_t* kp = QKV + (size_t)(j * 256 + part * 64) * 3072 + 1024 + h * 128 + d;
        float s = 0.f;
        for (int i = 0; i < 64; ++i) s += bf2f(kp[(size_t)i * 3072]);
        __syncthreads();
        red[tid] = s;
        __syncthreads();
        if (tid < 128) {
            const float km = ((red[tid] + red[tid + 128]) + (red[tid + 256] + red[tid + 384])) * (1.0f / 256.0f);
            const unsigned hb = cvtpk(km, 0.f) & 0xffffu; const float hf = bf2f((unsigned short)hb);
            const unsigned lb = cvtpk(km - hf, 0.f) & 0xffffu;
            KMH[item * 128 + tid] = (bf16_t)hb; KML[item * 128 + tid] = (bf16_t)lb;
        }
    }
}
#define TOP3_INS(v_, i_) do { const float vv_ = (v_); const int ii_ = (i_); \
    if (vv_ > v1 || (vv_ == v1 && ii_ < i1)) { v3 = v2; i3 = i2; v2 = v1; i2 = i1; v1 = vv_; i1 = ii_; } \
    else if (vv_ > v2 || (vv_ == v2 && ii_ < i2)) { v3 = v2; i3 = i2; v2 = vv_; i2 = ii_; } \
    else if (vv_ > v3 || (vv_ == v3 && ii_ < i3)) { v3 = vv_; i3 = ii_; } } while (0)
DI void moba_gate_phase(const Params& P) {
    const bf16_t* QKV = (const bf16_t*)(P.ws + WS_QKV); const bf16_t* KMH = (const bf16_t*)(P.ws + WS_KMH); const bf16_t* KML = (const bf16_t*)(P.ws + WS_KML);
    unsigned* cnt = (unsigned*)(P.ws + WS_CTL) + CTL_CNT; unsigned short* list = (unsigned short*)(P.ws + WS_LIST); float2* ML = (float2*)(P.ws + WS_ML);
    const int tid = threadIdx.x, w = tid >> 6, lane = tid & 63, r32 = lane & 31, hi = lane >> 5;
    unsigned* lcnt = (unsigned*)g_lds; unsigned* lbase = lcnt + 64;
    for (int item = blockIdx.x; item < 512; item += gridDim.x) {
        const int h = item & 7, tq = item >> 3;
        const int q = tq * 256 + w * 32 + r32;
        float v1 = -3e38f, v2 = -3e38f, v3 = -3e38f; int i1 = 255, i2 = 255, i3 = 255;
        if (tq > 0) {
            bf16x8 qr[8];
            { const bf16_t* qp = QKV + (size_t)q * 3072 + h * 128 + hi * 8;
#pragma unroll
              for (int d0 = 0; d0 < 8; ++d0) qr[d0] = *(const bf16x8*)(qp + d0 * 16); }
#pragma unroll
            for (int u = 0; u < 2; ++u) {
                if (32 * u < tq) {
                    f32x16 g = {};
                    const size_t ko = (size_t)((h * 64 + 32 * u + r32) * 128 + hi * 8);
#pragma unroll
                    for (int d0 = 0; d0 < 8; ++d0) {
                        g = MFMA32(*(const bf16x8*)(KMH + ko + d0 * 16), qr[d0], g);
                        g = MFMA32(*(const bf16x8*)(KML + ko + d0 * 16), qr[d0], g);
                    }
#pragma unroll
                    for (int r = 0; r < 16; ++r) { const int blk = 32 * u + crow(r, hi); if (blk < tq) TOP3_INS(g[r], blk); }
                }
            }
            const float pv1 = __shfl_xor(v1, 32), pv2 = __shfl_xor(v2, 32), pv3 = __shfl_xor(v3, 32);
            const int pi1 = __shfl_xor(i1, 32), pi2 = __shfl_xor(i2, 32), pi3 = __shfl_xor(i3, 32);
            if (pi1 < 255) TOP3_INS(pv1, pi1);
            if (pi2 < 255) TOP3_INS(pv2, pi2);
            if (pi3 < 255) TOP3_INS(pv3, pi3);
        }
        __syncthreads();
        if (tid < 64) { lcnt[tid] = 0u; }
        __syncthreads();
        const int sel[3] = {i1, i2, i3};
        unsigned lpos[3] = {0u, 0u, 0u};
        if (hi == 0) {
#pragma unroll
            for (int s = 0; s < 3; ++s) {
                if (sel[s] < 255) lpos[s] = atomicAdd(&lcnt[sel[s]], 1u);
                else ML[(size_t)(q * 8 + h) * 3 + s] = make_float2(-1e30f, 0.f);
            }
        }
        __syncthreads();
        if (tid < 64) { const unsigned c = lcnt[tid]; lbase[tid] = c ? atomicAdd(&cnt[h * 64 + tid], c) : 0u; }
        __syncthreads();
        if (hi == 0) {
#pragma unroll
            for (int s = 0; s < 3; ++s)
                if (sel[s] < 255) list[(size_t)(h * 64 + sel[s]) * 16384 + lbase[sel[s]] + lpos[s]] = (unsigned short)((q << 2) | s);
        }
    }
}
#define MB_DECL int mb_k[2], mb_v[2]; \
    _Pragma("unroll") for (int i = 0; i < 2; ++i) { const int kr_ = (i * 8 + w) * 4 + (lane >> 4), c_ = (lane & 15) ^ (kr_ & 15); mb_k[i] = kr_ * 3072 + 1024 + c_ * 8; \
        const int key_ = (i * 8 + w) * 4 + ((lane >> 2) & 3), col_ = (lane >> 4) * 32 + (lane & 3) * 8; mb_v[i] = key_ * 3072 + 2048 + col_; }
#define MB_ISSUE(key0_, b_) do { const bf16_t* g_ = QKV + (size_t)(key0_) * 3072 + h * 128; \
    _Pragma("unroll") for (int i = 0; i < 2; ++i) { dma16(g_ + mb_k[i], AL_K0 + (b_) * AL_KB + (i * 8 + w) * 1024); dma16(g_ + mb_v[i], AL_V0 + (b_) * AL_VB + (i * 8 + w) * 1024); } } while (0)

DI void moba_sel_phase(const Params& P) {
    const bf16_t* QKV = (const bf16_t*)(P.ws + WS_QKV);
    const unsigned* cnt = (const unsigned*)(P.ws + WS_CTL) + CTL_CNT; const unsigned short* list = (const unsigned short*)(P.ws + WS_LIST);
    float2* ML = (float2*)(P.ws + WS_ML); bf16_t* PART = (bf16_t*)(P.ws + WS_PART);
    const int tid = threadIdx.x, w = __builtin_amdgcn_readfirstlane(tid >> 6), lane = tid & 63, r32 = lane & 31, hi = lane >> 5;
    int* pre = (int*)(g_lds + 100 * 1024);
    float* alw = (float*)(g_lds + AL_W + w * 512);
    unsigned* cdw = (unsigned*)(alw + 32);
    __syncthreads();
    pre[tid + 1] = (int)((__hip_atomic_load(cnt + tid, __ATOMIC_RELAXED, __HIP_MEMORY_SCOPE_AGENT) + 255u) >> 8);
    __syncthreads();
    if (tid == 0) { int a = 0; pre[0] = 0; for (int i = 1; i <= 512; ++i) { a += pre[i]; pre[i] = a; } }
    __syncthreads();
    const int T = pre[512];
    const unsigned vb0 = (unsigned)(uintptr_t)(g_lds + AL_V0) + v_lane_base(lane);
    const KBase<8> kb = make_kbase<8>(r32, hi);
    MB_DECL;
    for (int cid = blockIdx.x; cid < T; cid += gridDim.x) {
        int lo = 0, hi_ = 512;
        while (hi_ - lo > 1) { const int mid = (lo + hi_) >> 1; if (pre[mid] <= cid) lo = mid; else hi_ = mid; }
        const int hj = lo, h = hj >> 6, j = hj & 63, c = cid - pre[hj];
        const int n = (int)__hip_atomic_load(cnt + hj, __ATOMIC_RELAXED, __HIP_MEMORY_SCOPE_AGENT);
        const int e0 = c * 256 + w * 32;
        const bool wact = e0 < n;
        const bool valid = (e0 + r32) < n;
        const unsigned code = list[(size_t)hj * 16384 + (valid ? (e0 + r32) : (wact ? e0 : 0))];
        const int q = (int)(code >> 2), slot = (int)(code & 3);
        bf16x8 qr[8];
        { const bf16_t* qp = QKV + (size_t)q * 3072 + h * 128 + hi * 8;
#pragma unroll
          for (int d0 = 0; d0 < 8; ++d0) qr[d0] = *(const bf16x8*)(qp + d0 * 16); }
        f32x16 o[4] = {};
        float m = -1e30f, l = 0.f;
        MB_ISSUE(j * 256, 0); VM_DRAIN();
        __syncthreads();
#pragma unroll 1
        for (int t = 0; t < 4; ++t) {
            const int b = t & 1;
            if (t + 1 < 4) MB_ISSUE(j * 256 + (t + 1) * 64, b ^ 1);
            if (wact) attn_tile<8>(AL_K0 + b * AL_KB, vb0 + b * AL_VB, kb, qr, o, m, l, false, 0, alw, r32, hi);
            VM_DRAIN();
            __syncthreads();
        }
        if (wact) {
            const float lt = l + __shfl_xor(l, 32);
            if (hi == 0) { alw[r32] = __builtin_amdgcn_rcpf(lt); cdw[r32] = valid ? code : 0xffffffffu; if (valid) ML[(size_t)(q * 8 + h) * 3 + slot] = make_float2(m, lt); }
            asm volatile("s_waitcnt lgkmcnt(0)" ::: "memory");
#pragma unroll
            for (int r = 0; r < 16; ++r) { const int orow = crow(r, hi); const float inv = alw[orow]; const unsigned cd = cdw[orow];
                bf16_t* dst = PART + ((size_t)((cd >> 2) * 3 + (cd & 3)) * 8 + h) * 128;
#pragma unroll
                for (int d0 = 0; d0 < 4; ++d0) { const float v = o[d0][r] * inv; const float vn = __shfl_xor(v, 1);
                    if ((r32 & 1) == 0 && cd != 0xffffffffu) *(unsigned*)(dst + d0 * 32 + r32) = cvtpk(v, vn); } }
            asm volatile("s_waitcnt lgkmcnt(0)" ::: "memory");
        }
    }
}
DI void moba_own_phase(const Params& P) {
    bf16_t* QKV = (bf16_t*)(P.ws + WS_QKV);
    const float2* ML = (const float2*)(P.ws + WS_ML); const bf16_t* PART = (const bf16_t*)(P.ws + WS_PART);
    const int tid = threadIdx.x, w = __builtin_amdgcn_readfirstlane(tid >> 6), lane = tid & 63, r32 = lane & 31, hi = lane >> 5;
    float* alw = (float*)(g_lds + AL_W + w * 512);
    const unsigned vb0 = (unsigned)(uintptr_t)(g_lds + AL_V0) + v_lane_base(lane);
    const KBase<8> kb = make_kbase<8>(r32, hi);
    MB_DECL;
    for (int item = blockIdx.x; item < 512; item += gridDim.x) {
        const int h = item & 7, tq = item >> 3;
        const int q = tq * 256 + w * 32 + r32;
        bf16x8 qr[8];
        { const bf16_t* qp = QKV + (size_t)q * 3072 + h * 128 + hi * 8;
#pragma unroll
          for (int d0 = 0; d0 < 8; ++d0) qr[d0] = *(const bf16x8*)(qp + d0 * 16); }
        f32x16 o[4] = {};
        float m = -1e30f, l = 0.f;
        const int tmax = w >> 1;
        MB_ISSUE(tq * 256, 0); VM_DRAIN();
        __syncthreads();
#pragma unroll 1
        for (int t = 0; t < 4; ++t) {
            const int b = t & 1;
            if (t + 1 < 4) MB_ISSUE(tq * 256 + (t + 1) * 64, b ^ 1);
            if (t <= tmax) attn_tile<8>(AL_K0 + b * AL_KB, vb0 + b * AL_VB, kb, qr, o, m, l, t == tmax, w * 32 + r32 - t * 64, alw, r32, hi);
            VM_DRAIN();
            __syncthreads();
        }
        const float lt = l + __shfl_xor(l, 32);
        const float2* mlp = ML + (size_t)(q * 8 + h) * 3;
        const float2 a0 = mlp[0], a1 = mlp[1], a2 = mlp[2];
        const float M = fmaxf(fmaxf(m, a0.x), fmaxf(a1.x, a2.x));
        const float wo = __builtin_amdgcn_exp2f(m - M);
        const float w0 = a0.y > 0.f ? a0.y * __builtin_amdgcn_exp2f(a0.x - M) : 0.f;
        const float w1 = a1.y > 0.f ? a1.y * __builtin_amdgcn_exp2f(a1.x - M) : 0.f;
        const float w2 = a2.y > 0.f ? a2.y * __builtin_amdgcn_exp2f(a2.x - M) : 0.f;
        const float inv = __builtin_amdgcn_rcpf(lt * wo + w0 + w1 + w2);
        if (hi == 0) { alw[r32] = wo * inv; alw[32 + r32] = w0 * inv; alw[64 + r32] = w1 * inv; alw[96 + r32] = w2 * inv; }
        asm volatile("s_waitcnt lgkmcnt(0)" ::: "memory");
        float* ob = (float*)g_lds + w * (32 * 68);
        const int rr = lane >> 1, cs = (lane & 1) * 32;
        const float c1 = alw[32 + rr], c2 = alw[64 + rr], c3 = alw[96 + rr];
        bf16_t* Ow = QKV + (size_t)(tq * 256 + w * 32 + rr) * 3072 + h * 128 + cs;
        const bf16_t* pp = PART + ((size_t)(tq * 256 + w * 32 + rr) * 24 + h) * 128 + cs;
#pragma unroll
        for (int half = 0; half < 2; ++half) {
#pragma unroll
            for (int r = 0; r < 16; ++r) { const int orow = crow(r, hi); const float c0 = alw[orow];
                ob[orow * 68 + r32] = o[2 * half][r] * c0; ob[orow * 68 + 32 + r32] = o[2 * half + 1][r] * c0; }
            asm volatile("s_waitcnt lgkmcnt(0)" ::: "memory");
            bf16x8 s0[4], s1[4], s2[4];
#pragma unroll
            for (int i = 0; i < 4; ++i) { s0[i] = *(const bf16x8*)(pp + half * 64 + i * 8); s1[i] = *(const bf16x8*)(pp + 1024 + half * 64 + i * 8); s2[i] = *(const bf16x8*)(pp + 2048 + half * 64 + i * 8); }
#pragma unroll
            for (int i = 0; i < 4; ++i) {
                const f32x4 a = *(const f32x4*)(ob + rr * 68 + cs + i * 8), bq = *(const f32x4*)(ob + rr * 68 + cs + i * 8 + 4);
                float v[8] = {a[0], a[1], a[2], a[3], bq[0], bq[1], bq[2], bq[3]};
#pragma unroll
                for (int j = 0; j < 8; ++j) {
                    v[j] += (c1 > 0.f) ? c1 * bf2f((unsigned short)s0[i][j]) : 0.f;
                    v[j] += (c2 > 0.f) ? c2 * bf2f((unsigned short)s1[i][j]) : 0.f;
                    v[j] += (c3 > 0.f) ? c3 * bf2f((unsigned short)s2[i][j]) : 0.f;
                }
                u32x4 wv = {cvtpk(v[0], v[1]), cvtpk(v[2], v[3]), cvtpk(v[4], v[5]), cvtpk(v[6], v[7])};
                *(u32x4*)(Ow + half * 64 + i * 8) = wv;
            }
            asm volatile("s_waitcnt lgkmcnt(0)" ::: "memory");
        }
        __syncthreads();
    }
}

#define XB_TMO      128
#define XB_XCNT(j)  (256  + 64 * (j))
#define XB_XSUB(j)  (1280 + 64 * (j))
#define XB_XGEN(j)  (2304 + 64 * (j))
#define XB_TOP      3328
#define XB_TOPGEN   3392
#define XB_SPIN_CAP (1u << 18)
DI unsigned xb_ld(unsigned* p)              { return __hip_atomic_load(p, __ATOMIC_RELAXED, __HIP_MEMORY_SCOPE_AGENT); }
DI unsigned xb_add(unsigned* p, unsigned v) { return __hip_atomic_fetch_add(p, v, __ATOMIC_RELAXED, __HIP_MEMORY_SCOPE_AGENT); }
DI unsigned xb_xcc_id() { return (unsigned)__builtin_amdgcn_s_getreg((3 << 11) | 20) & 0xFu; }
#define XB_SPIN(cond, bar) do { unsigned _sp = 0; while (cond) { __builtin_amdgcn_s_sleep(1); \
    if ((++_sp & 255u) == 0u) { if (xb_ld(&(bar)[XB_TMO])) break; if (_sp > XB_SPIN_CAP) { atomicAdd(&(bar)[XB_TMO], 1u); break; } } } } while (0)
struct XcdBarrier { unsigned* bar; unsigned x; volatile LAS unsigned* st; };
DI XcdBarrier xcd_barrier_post(unsigned* bar, volatile LAS unsigned* st) {
    XcdBarrier b; b.bar = bar; b.x = xb_xcc_id(); b.st = st;
    if (threadIdx.x == 0) (void)xb_add(&bar[XB_XCNT(b.x)], 1u);
    return b;
}
DI void xcd_barrier_complete(unsigned* bar, unsigned x, unsigned& nloc, unsigned& nx) {
    const unsigned G = gridDim.x * gridDim.y * gridDim.z;
    unsigned sum, cnt, mine, sp = 0u;
    for (;;) {
        sum = 0u; cnt = 0u; mine = 0u;
#pragma unroll
        for (unsigned j = 0; j < 16; ++j) { const unsigned c = xb_ld(&bar[XB_XCNT(j)]); sum += c; cnt += (c > 0u) ? 1u : 0u; mine = (j == x) ? c : mine; }
        if (sum == G) break;
        __builtin_amdgcn_s_sleep(1);
        if ((++sp & 255u) == 0u) { if (xb_ld(&bar[XB_TMO])) break; if (sp > XB_SPIN_CAP) { atomicAdd(&bar[XB_TMO], 1u); break; } }
    }
    nloc = mine > 0u ? mine : 1u; nx = cnt > 0u ? cnt : 1u;
}
DI void xcd_barrier(const XcdBarrier& b) {
    asm volatile("s_waitcnt vmcnt(0)" ::: "memory");
    __syncthreads();
    if (threadIdx.x == 0) {
        unsigned* bar = b.bar;
        __builtin_amdgcn_s_waitcnt(0);
        unsigned nloc = b.st[0], nx = b.st[1];
        if (nloc == 0u) { xcd_barrier_complete(bar, b.x, nloc, nx); b.st[0] = nloc; b.st[1] = nx; }
        const unsigned old = xb_add(&bar[XB_XSUB(b.x)], 1u);
        const unsigned gen = old / nloc;
        if (old + 1u == (gen + 1u) * nloc) {
            __builtin_amdgcn_fence(__ATOMIC_RELEASE, "agent");
            asm volatile("s_waitcnt vmcnt(0)" ::: "memory");
            const unsigned og = xb_add(&bar[XB_TOP], 1u);
            const unsigned tg = og / nx;
            if (og + 1u == (tg + 1u) * nx) xb_add(&bar[XB_TOPGEN], 1u);
            else XB_SPIN(xb_ld(&bar[XB_TOPGEN]) == tg, bar);
            __builtin_amdgcn_fence(__ATOMIC_ACQUIRE, "agent");
            xb_add(&bar[XB_XGEN(b.x)], 1u);
            asm volatile("s_waitcnt vmcnt(0)" ::: "memory");
        } else {
            XB_SPIN(xb_ld(&bar[XB_XGEN(b.x)]) == gen, bar);
            __builtin_amdgcn_fence(__ATOMIC_ACQUIRE, "agent");
            asm volatile("s_waitcnt vmcnt(0)" ::: "memory");
        }
    }
    __syncthreads();
}

constexpr int NPHASE = 19;
__global__ void __launch_bounds__(NTHR) fwd_megakernel(Params P) {
    unsigned char* ws = P.ws;
    const float* cosM = (const float*)(ws + WS_COSM); const float* sinM = (const float*)(ws + WS_SINM);
    const float* cosB = (const float*)(ws + WS_COSB); const float* sinB = (const float*)(ws + WS_SINB);
    bf16_t* XB = (bf16_t*)(ws + WS_XB);
    float* XF = P.out;
    const int lo = P.ph_lo, hi = P.ph_hi;
#define IN(k) (lo <= (k) && (k) < hi)
    volatile LAS unsigned* xst = (volatile LAS unsigned*)((LAS unsigned char*)g_lds + 131072 + 4096);
    if (threadIdx.x < 2) xst[threadIdx.x] = 0u;
    __syncthreads();
    XcdBarrier xbar; xbar.bar = (unsigned*)(ws + WS_CTL) + 4096; xbar.x = 0; xbar.st = xst;
    if (hi - lo > 1) xbar = xcd_barrier_post((unsigned*)(ws + WS_CTL) + 4096, xst);
    if (lo < 0) cg::this_grid().sync();
#define SEAM(k) do { if (IN(k) && IN((k) + 1)) xcd_barrier(xbar); } while (0)
    if (IN(0)) prep_phase(P);
    SEAM(0);
    if (IN(1)) { EpiLat e{(bf16_t*)(ws + WS_LAT), (bf16_t*)(ws + WS_KR), cosM, sinM, P.out  };
        gemm_phase(XB, 1024, (const bf16_t*)(ws + WS_W0_DQKV), 1024, 64, 3, e); }
    SEAM(1);
    if (IN(2)) {
        { EpiQ e{P.out, (bf16_t*)(ws + WS_Q), cosM, sinM};
          gemm_phase((const bf16_t*)(ws + WS_LAT), 640, (const bf16_t*)(ws + WS_W0_UQ), 384, 64, 6, e); }
        { EpiKV e{P.out, (bf16_t*)(ws + WS_KV)};
          gemm_phase((const bf16_t*)(ws + WS_LAT) + 384, 640, (const bf16_t*)(ws + WS_W0_UKV), 256, 64, 8, e, 128); }
    }
    SEAM(2);
    if (IN(3)) mla_attn_phase(P);
    SEAM(3);
    if (IN(4)) { EpiRes e{P.in[0], (float*)(ws + WS_Y)};
        gemm_phase((const bf16_t*)(ws + WS_AO), 1024, (const bf16_t*)(ws + WS_W0_O), 1024, 64, 4, e); }
    SEAM(4);
    if (IN(5)) ln_phase((const float*)(ws + WS_Y), P.in[11], P.in[12], XF, XB);
    SEAM(5);
    if (IN(6)) { EpiSwiglu e{(bf16_t*)(ws + WS_H)};
        gemm_phase(XB, 1024, (const bf16_t*)(ws + WS_W0_IN), 1024, 64, 22, e); }
    SEAM(6);
    if (IN(7)) { EpiRes e{XF, (float*)(ws + WS_Y)};
        gemm_phase((const bf16_t*)(ws + WS_H), DFF, (const bf16_t*)(ws + WS_W0_OUT), DFF, 64, 4, e); }
    SEAM(7);
    if (IN(8)) ln_phase((const float*)(ws + WS_Y), P.in[13], P.in[14], XF, XB);
    SEAM(8);
    if (IN(9)) { EpiMobaQKV e{(bf16_t*)(ws + WS_QKV), cosB, sinB};
        gemm_phase(XB, 1024, (const bf16_t*)(ws + WS_W1_QKV), 1024, 64, 12, e); }
    SEAM(9);
    if (IN(10)) moba_kmean_phase(P);
    SEAM(10);
    if (IN(11)) moba_gate_phase(P);
    SEAM(11);
    if (IN(12)) moba_sel_phase(P);
    SEAM(12);
    if (IN(13)) moba_own_phase(P);
    SEAM(13);
    if (IN(14)) { EpiRes e{XF, (float*)(ws + WS_Y1)};
        gemm_phase((const bf16_t*)(ws + WS_QKV), 3072, (const bf16_t*)(ws + WS_W1_O), 1024, 64, 4, e); }
    SEAM(14);
    if (IN(15)) ln_phase((const float*)(ws + WS_Y1), P.in[11] + DM, P.in[12] + DM, XF, XB);
    SEAM(15);
    if (IN(16)) { EpiSwiglu e{(bf16_t*)(ws + WS_H)};
        gemm_phase(XB, 1024, (const bf16_t*)(ws + WS_W1_IN), 1024, 64, 22, e); }
    SEAM(16);
    if (IN(17)) { EpiRes e{XF, (float*)(ws + WS_Y)};
        gemm_phase((const bf16_t*)(ws + WS_H), DFF, (const bf16_t*)(ws + WS_W1_OUT), DFF, 64, 4, e); }
    SEAM(17);
    if (IN(18)) ln_phase((const float*)(ws + WS_Y), P.in[13] + DM, P.in[14] + DM, XF, nullptr);
#undef IN
#undef SEAM
}

extern "C" void kernel_launch(void* const* d_in, const int* in_sizes, int n_in, void* d_out, int out_size, void* d_ws, size_t ws_size, hipStream_t stream) {
    static int grid = 0;
    if (grid == 0) {
        if (n_in != 15 || out_size != S * DM || ws_size < WS_END) { fprintf(stderr, "kernel_launch: unexpected shapes (n_in %d out %d ws %zu)\n", n_in, out_size, ws_size); grid = -1; return; }
        int dev = 0, cus = 0, per_cu = 0;
        (void)hipGetDevice(&dev);
        (void)hipDeviceGetAttribute(&cus, hipDeviceAttributeMultiprocessorCount, dev);
        (void)hipFuncSetAttribute((const void*)fwd_megakernel, hipFuncAttributeMaxDynamicSharedMemorySize, LDS_BYTES);
        (void)hipOccupancyMaxActiveBlocksPerMultiprocessor(&per_cu, (const void*)fwd_megakernel, NTHR, LDS_BYTES);
        if (per_cu < 1) per_cu = 1;
        grid = cus * per_cu;
        if (grid <= 0) grid = 256;
    }
    if (grid < 0) return;
    (void)hipMemsetAsync((char*)d_ws + WS_CTL, 0, 1 * MiB, stream);
    Params p{};
    for (int i = 0; i < 15; ++i) p.in[i] = (const float*)d_in[i];
    p.out = (float*)d_out; p.ws = (unsigned char*)d_ws;
#if MK_MULTI
    for (int ph = 0; ph < NPHASE; ++ph) {
        p.ph_lo = ph; p.ph_hi = ph + 1;
        for (int rep = 0; rep < (((PROBE_MASK >> ph) & 1u) ? 2 : 1); ++rep)
            hipLaunchKernelGGL(fwd_megakernel, dim3(grid), dim3(NTHR), LDS_BYTES, stream, p);
    }
#else
    p.ph_lo = 0; p.ph_hi = NPHASE;
    void* args[] = {&p};
    hipError_t e = hipLaunchCooperativeKernel((const void*)fwd_megakernel, dim3(grid), dim3(NTHR), args, LDS_BYTES, stream);
    if (e != hipSuccess) fprintf(stderr, "cooperative launch failed: %s (grid %d)\n", hipGetErrorString(e), grid);
#endif
}
```

```cpp
#include <hip/hip_runtime.h>
#include <hip/hip_cooperative_groups.h>
#include <cstdint>
#include <cstdio>
namespace cg = cooperative_groups;

#ifndef MK_MULTI
#define MK_MULTI 0
#endif
#define PROBE_MASK 0u

#define DI __device__ __forceinline__
typedef unsigned short bf16_t;
typedef short bf16x8 __attribute__((ext_vector_type(8)));
typedef short s16x4 __attribute__((ext_vector_type(4)));
typedef float f32x4 __attribute__((ext_vector_type(4)));
typedef float f32x16 __attribute__((ext_vector_type(16)));
typedef unsigned u32x4 __attribute__((ext_vector_type(4)));
typedef unsigned u32x2 __attribute__((ext_vector_type(2)));

constexpr int S = 16384, DM = 1024, DFF = 2816;
constexpr int NTHR = 512;
constexpr size_t MiB = 1u << 20;
constexpr size_t WS_CTL = 0;
constexpr size_t WS_COSM = 1 * MiB, WS_SINM = 3 * MiB;
constexpr size_t WS_COSB = 5 * MiB, WS_SINB = 6 * MiB;
constexpr size_t WS_KMH = 7 * MiB, WS_KML = 7 * MiB + 131072;
constexpr size_t WS_W1_QKV = 8 * MiB, WS_W1_O = 14 * MiB, WS_W1_IN = 16 * MiB, WS_W1_OUT = 27 * MiB;
constexpr size_t WS_W0_DQKV = 33 * MiB, WS_W0_UQ = 35 * MiB, WS_W0_UKV = 37 * MiB, WS_W0_O = 38 * MiB, WS_W0_IN = 40 * MiB, WS_W0_OUT = 51 * MiB;
constexpr size_t WS_XB = 57 * MiB;
constexpr size_t WS_R = 89 * MiB;
constexpr size_t WS_AO = WS_R, WS_LAT = WS_R + 32 * MiB, WS_KR = WS_R + 52 * MiB, WS_Q = WS_R + 54 * MiB, WS_KV = WS_R + 102 * MiB;
constexpr size_t WS_Y = WS_R + 102 * MiB;
constexpr size_t WS_H = WS_R;
constexpr size_t WS_ML = 33 * MiB;
constexpr size_t WS_LIST = 36 * MiB;
constexpr size_t WS_PART = 57 * MiB;
constexpr size_t WS_QKV = 153 * MiB;
constexpr size_t WS_Y1 = 89 * MiB;
constexpr size_t WS_END = 256 * MiB;
constexpr int CTL_CNT = 16384;

constexpr int LDS_BYTES = 131072 + 8192;
extern __shared__ __attribute__((aligned(16))) unsigned char g_lds[];

struct Params { const float* in[15]; float* out; unsigned char* ws; int ph_lo, ph_hi; };

DI unsigned cvtpk(float lo, float hi) { unsigned r; asm("v_cvt_pk_bf16_f32 %0, %1, %2" : "=v"(r) : "v"(lo), "v"(hi)); return r; }
DI float bf2f(unsigned short v) { return __uint_as_float((unsigned)v << 16); }
DI int crow(int r, int hi) { return (r & 3) + 8 * (r >> 2) + 4 * hi; }
DI float wave_sum(float v) {
#pragma unroll
    for (int o = 1; o < 64; o <<= 1) v += __shfl_xor(v, o);
    return v;
}

__device__ const double kInvFreq[32] = {1.0, 0.6636012376960885, 0.44036660267178046, 0.2922278225730151, 0.19392274474868576, 0.12868737343265052, 0.08539710028576561, 0.05666962144529105, 0.03760603093086393, 0.024955408670558694, 0.016560440080994446, 0.010989528534539826, 0.007292664737217109, 0.004839421345719893, 0.003211445994752591, 0.0021311195369119653, 0.001414213562373095, 0.0009384738703573802, 0.000622772421914596, 0.0004132725499855165, 0.0002742481756762073, 0.00018199142881462546, 0.00012076973741146504, 8.01429472224798e-05, 5.318295896944988e-05, 3.529227739646723e-05, 2.341999896140934e-05, 1.5541540297632344e-05, 1.031338537721246e-05, 6.8439753011549275e-06, 4.5416704806078695e-06, 3.013858152139171e-06};

DI int srcmap(int code, int n) {
    switch (code) {
        case 1: { if (n < 640) return n; if (n < 704) { int j = n - 640; return 640 + (j >> 1) + 32 * (j & 1); } return -1; }
        case 2: { int h = n / 192, c = n - h * 192; if (c < 128) return n; int j = c - 128; return h * 192 + 128 + (j >> 1) + 32 * (j & 1); }
        case 3: { if (n >= 2048) return n; int c = n & 127; if (c >= 32) return n; return (n & ~127) + (c >> 1) + 16 * (c & 1); }
        case 4: { int q = n >> 5, t = (n >> 4) & 1, i = n & 15; return t * DFF + 16 * q + i; }
        default: return n;
    }
}
DI void wtrans(const float* __restrict__ W, int K, int N, bf16_t* __restrict__ Wt, int Np, int code, const float* __restrict__ kscale) {
    float* tile = (float*)g_lds;
    const int tid = threadIdx.x;
    const int tk = K / 64, tn = Np / 64, nt = tk * tn;
    for (int t = blockIdx.x; t < nt; t += gridDim.x) {
        const int n0 = (t / tk) * 64, k0 = (t % tk) * 64;
        __syncthreads();
        {
            const int nn = tid & 63; const int src = srcmap(code, n0 + nn);
#pragma unroll
            for (int i = 0; i < 8; ++i) {
                const int kk = (tid >> 6) + 8 * i;
                float v = 0.f;
                if (src >= 0) { v = W[(size_t)(k0 + kk) * N + src]; if (kscale) v *= kscale[k0 + kk]; }
                tile[kk * 65 + nn] = v;
            }
        }
        __syncthreads();
        {
            const int kk = (tid & 31) * 2;
#pragma unroll
            for (int i = 0; i < 4; ++i) {
                const int nn = (tid >> 5) + 16 * i;
                *(unsigned*)(Wt + (size_t)(n0 + nn) * K + k0 + kk) = cvtpk(tile[kk * 65 + nn], tile[(kk + 1) * 65 + nn]);
            }
        }
    }
}

DI void prep_phase(const Params& P) {
    unsigned char* ws = P.ws;
    const int tid = threadIdx.x;
    const size_t gt = (size_t)blockIdx.x * NTHR + tid, gs = (size_t)gridDim.x * NTHR;
    {
        const float* x = P.in[0]; bf16_t* xb = (bf16_t*)(ws + WS_XB);
        for (size_t i = gt; i < (size_t)S * DM / 8; i += gs) {
            const f32x4 a = *(const f32x4*)(x + i * 8), b = *(const f32x4*)(x + i * 8 + 4);
            u32x4 w = {cvtpk(a[0], a[1]), cvtpk(a[2], a[3]), cvtpk(b[0], b[1]), cvtpk(b[2], b[3])};
            *(u32x4*)(xb + i * 8) = w;
        }
    }
    {
        float* cm = (float*)(ws + WS_COSM); float* sm = (float*)(ws + WS_SINM); float* cb = (float*)(ws + WS_COSB); float* sb = (float*)(ws + WS_SINB);
        for (size_t i = gt; i < (size_t)S * 32; i += gs) {
            const int pos = (int)(i >> 5), f = (int)(i & 31);
            const double rev = (double)pos * kInvFreq[f] * 0.15915494309189535;
            const float fr = (float)(rev - floor(rev));
            const float c = __builtin_amdgcn_cosf(fr), s = __builtin_amdgcn_sinf(fr);
            cm[i] = c; sm[i] = s;
            if ((f & 1) == 0) { cb[pos * 16 + (f >> 1)] = c; sb[pos * 16 + (f >> 1)] = s; }
        }
    }
    wtrans(P.in[1], 1024, 704, (bf16_t*)(ws + WS_W0_DQKV), 768, 1, nullptr);
    wtrans(P.in[3], 384, 1536, (bf16_t*)(ws + WS_W0_UQ), 1536, 2, P.in[2]);
    wtrans(P.in[5], 256, 2048, (bf16_t*)(ws + WS_W0_UKV), 2048, 0, P.in[4]);
    wtrans(P.in[6], 1024, 1024, (bf16_t*)(ws + WS_W0_O), 1024, 0, nullptr);
    wtrans(P.in[7], 1024, 3072, (bf16_t*)(ws + WS_W1_QKV), 3072, 3, nullptr);
    wtrans(P.in[8], 1024, 1024, (bf16_t*)(ws + WS_W1_O), 1024, 0, nullptr);
    wtrans(P.in[9], 1024, 2 * DFF, (bf16_t*)(ws + WS_W0_IN), 2 * DFF, 4, nullptr);
    wtrans(P.in[9] + (size_t)1024 * 2 * DFF, 1024, 2 * DFF, (bf16_t*)(ws + WS_W1_IN), 2 * DFF, 4, nullptr);
    wtrans(P.in[10], DFF, 1024, (bf16_t*)(ws + WS_W0_OUT), 1024, 0, nullptr);
    wtrans(P.in[10] + (size_t)DFF * 1024, DFF, 1024, (bf16_t*)(ws + WS_W1_OUT), 1024, 0, nullptr);
}

DI void ln_phase(const float* __restrict__ Y, const float* __restrict__ g, const float* __restrict__ b, float* __restrict__ XF, bf16_t* __restrict__ XBo) {
    const int tid = threadIdx.x, wave = tid >> 6, lane = tid & 63;
    for (int row = blockIdx.x * 8 + wave; row < S; row += gridDim.x * 8) {
        const f32x4* yr = (const f32x4*)(Y + (size_t)row * DM);
        f32x4 v[4];
#pragma unroll
        for (int i = 0; i < 4; ++i) v[i] = yr[lane + 64 * i];
        float s = 0.f;
#pragma unroll
        for (int i = 0; i < 4; ++i) s += (v[i][0] + v[i][1]) + (v[i][2] + v[i][3]);
        s = wave_sum(s);
        const float mean = s * (1.0f / DM);
        float q = 0.f;
#pragma unroll
        for (int i = 0; i < 4; ++i) { const f32x4 d = v[i] - mean; q += (d[0] * d[0] + d[1] * d[1]) + (d[2] * d[2] + d[3] * d[3]); }
        q = wave_sum(q);
        const float rstd = rsqrtf(q * (1.0f / DM) + 1e-5f);
#pragma unroll
        for (int i = 0; i < 4; ++i) {
            const int col = (lane + 64 * i) * 4;
            const f32x4 gg = *(const f32x4*)(g + col), bb = *(const f32x4*)(b + col);
            const f32x4 o = (v[i] - mean) * rstd * gg + bb;
            *(f32x4*)(XF + (size_t)row * DM + col) = o;
            if (XBo) { u32x2 w = {cvtpk(o[0], o[1]), cvtpk(o[2], o[3])}; *(u32x2*)(XBo + (size_t)row * DM + col) = w; }
        }
    }
}

constexpr int BM = 256, BK = 64, HALF = 128, HT = HALF * BK, NXCD = 8, WGM = 8;
DI int lds_byte(int r, int c) { int st = (r >> 4) * 2 + (c >> 5), rr = r & 15, cc = c & 31, ob = rr * 64 + cc * 2; return st * 1024 + (ob ^ (((ob >> 9) & 1) << 5)); }
DI void stage_rc(int b, int& R, int& C) { int st = b / 1024, sb = b % 1024, swz = sb ^ (((sb >> 9) & 1) << 5); R = (st >> 1) * 16 + swz / 64; C = (st & 1) * 32 + (swz % 64) / 2; }

#define LAS __attribute__((address_space(3)))
struct Unit { int pm, pn; };
DI bool unit_next(int i, int G, int c, int nM, int nN, Unit& u) {
    const int nwg = nM * nN;
    const long L = (long)i * G + c; if (L >= nwg) return false;
    int wgid = (int)L;
    { const int q = nwg / NXCD, r = nwg % NXCD, xcd = wgid % NXCD, off = wgid / NXCD; wgid = (xcd < r ? xcd * (q + 1) : r * (q + 1) + (xcd - r) * q) + off; }
    const int nig = WGM * nN, gid = wgid / nig, fm = gid * WGM, gsz = (nM - fm) < WGM ? (nM - fm) : WGM;
    u.pm = fm + ((wgid % nig) % gsz); u.pn = (wgid % nig) / gsz; return true;
}
template <class Epi>
DI void gemm_phase(const bf16_t* __restrict__ A, int lda, const bf16_t* __restrict__ Bt, int K, int nM, int nN, const Epi& E, int cshift = 0) {
    LAS unsigned char* lds = (LAS unsigned char*)g_lds;
    constexpr int HTB = HT * 2;
#define SA(b, h) (((b) * 2 + (h)) * HTB)
#define SB(b, h) ((4 + (b) * 2 + (h)) * HTB)
#define STAGE(bufoff, gbase, voff) do { _Pragma("unroll") for (int _i = 0; _i < 2; ++_i) \
        __builtin_amdgcn_global_load_lds((const unsigned*)((const char*)(gbase) + (voff)[_i]), (LAS unsigned*)(lds + (bufoff) + ldsw + _i * 8192), 16, 0, 0); } while (0)
#define LDA(dst, b, h) do { _Pragma("unroll") for (int m = 0; m < 4; ++m) _Pragma("unroll") for (int k = 0; k < 2; ++k) dst[m][k] = *(const LAS bf16x8*)(lds + SA(b, h) + aoff + m * 2048 + k * 1024); } while (0)
#define LDB(dst, b, h) do { _Pragma("unroll") for (int n = 0; n < 2; ++n) _Pragma("unroll") for (int k = 0; k < 2; ++k) dst[n][k] = *(const LAS bf16x8*)(lds + SB(b, h) + boff + n * 2048 + k * 1024); } while (0)
#define MMA(ai, bj, At_, Bt_) do { __builtin_amdgcn_s_setprio(1); \
    _Pragma("unroll") for (int m = 0; m < 4; ++m) _Pragma("unroll") for (int n = 0; n < 2; ++n) _Pragma("unroll") for (int k = 0; k < 2; ++k) \
      acc[ai][bj][m][n] = __builtin_amdgcn_mfma_f32_16x16x32_bf16(Bt_[n][k], At_[m][k], acc[ai][bj][m][n], 0, 0, 0); \
    __builtin_amdgcn_s_setprio(0); } while (0)
#define WAIT_V(n) asm volatile("s_waitcnt vmcnt(" #n ")" ::: "memory")
#define WAIT_L(n) asm volatile("s_waitcnt lgkmcnt(" #n ")" ::: "memory")
#define BAR __builtin_amdgcn_s_barrier()
#define SCHED __builtin_amdgcn_sched_barrier(0)
#define ACC_ZERO() do { _Pragma("unroll") for (int a_ = 0; a_ < 2; ++a_) _Pragma("unroll") for (int b_ = 0; b_ < 2; ++b_) _Pragma("unroll") for (int m_ = 0; m_ < 4; ++m_) \
    _Pragma("unroll") for (int n_ = 0; n_ < 2; ++n_) acc[a_][b_][m_][n_] = (f32x4){0.f, 0.f, 0.f, 0.f}; } while (0)
    __syncthreads();
    int tid = threadIdx.x; asm volatile("" : "+v"(tid));
    const int wid = __builtin_amdgcn_readfirstlane(tid >> 6), lane = tid & 63, wr = wid >> 2, wc = wid & 3, fr = lane & 15, fq = lane >> 4;
    const int G = gridDim.x, c = ((int)blockIdx.x + cshift) % G;
    unsigned voffA[2], voffB[2];
#pragma unroll
    for (int i = 0; i < 2; ++i) { int R, C; stage_rc(tid * 16 + i * 8192, R, C); voffA[i] = (unsigned)(R * lda + C) * 2u; voffB[i] = (unsigned)(R * K + C) * 2u; }
    const size_t kstep = (size_t)(BK * 2), hA = (size_t)HALF * lda * 2, hB = (size_t)HALF * K * 2;
    const unsigned ldsw = (unsigned)wid * 1024u;
    const int aoff = lds_byte(wr * 64 + fr, fq * 8), boff = lds_byte(wc * 32 + fr, fq * 8);
    const int nt = K / BK;
    Unit cur, nxt; int ui = 0;
    if (!unit_next(0, G, c, nM, nN, cur)) return;
    f32x4 acc[2][2][4][2];
    ACC_ZERO();
    bf16x8 At[4][2], B0[2][2], B1[2][2];
    const char* cA = (const char*)A + (size_t)cur.pm * 2 * hA; const char* cB = (const char*)Bt + (size_t)cur.pn * 2 * hB;
    STAGE(SB(0, 0), cB, voffB); STAGE(SB(0, 1), cB + hB, voffB); STAGE(SA(0, 0), cA, voffA); STAGE(SA(0, 1), cA + hA, voffA);
    if (wr == 1) BAR;
    WAIT_V(2); BAR;
    STAGE(SB(1, 0), cB + kstep, voffB); STAGE(SA(1, 0), cA + kstep, voffA); STAGE(SB(1, 1), cB + hB + kstep, voffB);
    WAIT_V(6); BAR;
    for (;;) {
        const bool has_next = unit_next(ui + 1, G, c, nM, nN, nxt);
        const char* nA = has_next ? (const char*)A + (size_t)nxt.pm * 2 * hA : cA; const char* nB = has_next ? (const char*)Bt + (size_t)nxt.pn * 2 * hB : cB;
#pragma unroll 1
        for (int t = 0; t < nt; t += 2) {
            const bool last = (t == nt - 2);
            const char* a1 = cA + (size_t)(t + 1) * kstep;
            const char* a2 = last ? nA : cA + (size_t)(t + 2) * kstep; const char* b2 = last ? nB : cB + (size_t)(t + 2) * kstep;
            const char* a3 = a2 + kstep; const char* b3 = b2 + kstep;
            LDB(B0, 0, 0); LDB(B1, 0, 1); SCHED; LDA(At, 0, 0); STAGE(SA(1, 1), a1 + hA, voffA);
            WAIT_V(8); WAIT_L(0); BAR; MMA(0, 0, At, B0); MMA(0, 1, At, B1); BAR; SCHED;
            LDA(At, 0, 1); STAGE(SB(0, 0), b2, voffB); STAGE(SB(0, 1), b2 + hB, voffB); STAGE(SA(0, 0), a2, voffA);
            WAIT_V(8); WAIT_L(0); BAR; MMA(1, 0, At, B0); MMA(1, 1, At, B1); BAR; SCHED;
            LDB(B0, 1, 0); LDB(B1, 1, 1); SCHED; LDA(At, 1, 0); STAGE(SA(0, 1), a2 + hA, voffA);
            WAIT_V(8); WAIT_L(0); BAR; MMA(0, 0, At, B0); MMA(0, 1, At, B1); BAR; SCHED;
            LDA(At, 1, 1); STAGE(SB(1, 0), b3, voffB); STAGE(SB(1, 1), b3 + hB, voffB); STAGE(SA(1, 0), a3, voffA);
            WAIT_V(8); WAIT_L(0); BAR; MMA(1, 0, At, B0); MMA(1, 1, At, B1); BAR; SCHED;
        }
        if (wr == 0) BAR;
        if (Epi::HAS_PRE) { E.pre(cur.pm); __syncthreads(); }
        { int t2 = threadIdx.x; asm volatile("" : "+v"(t2));
          const int w2 = t2 >> 6, l2 = t2 & 63;
          E(acc, cur.pm, cur.pn, w2 >> 2, w2 & 3, l2 & 15, l2 >> 4); }
        if (!has_next) break;
        ACC_ZERO();
        cur = nxt; cA = nA; cB = nB; ++ui;
        if (wr == 1) BAR;
    }
    WAIT_V(0);
    BAR;
#undef SA
#undef SB
#undef STAGE
#undef LDA
#undef LDB
#undef MMA
#undef ACC_ZERO
}

#define EPI_LOOP_BEGIN \
    _Pragma("unroll") for (int ai = 0; ai < 2; ++ai) _Pragma("unroll") for (int m = 0; m < 4; ++m) { \
        const int rl = ai * HALF + wr * 64 + m * 16 + fr; const int row = pm * BM + rl; (void)rl; \
        _Pragma("unroll") for (int bj = 0; bj < 2; ++bj) _Pragma("unroll") for (int n = 0; n < 2; ++n) { \
            const int col = pn * BM + bj * HALF + wc * 32 + n * 16 + fq * 4; f32x4 v = acc[ai][bj][m][n];
#define EPI_LOOP_END } }

DI void st_bf4(bf16_t* p, f32x4 v) { u32x2 w = {cvtpk(v[0], v[1]), cvtpk(v[2], v[3])}; *(u32x2*)p = w; }
DI f32x4 rope4(f32x4 v, const float* ct, const float* st) {
    const float c0 = ct[0], s0 = st[0], c1 = ct[1], s1 = st[1];
    return (f32x4){v[0] * c0 - v[1] * s0, v[1] * c0 + v[0] * s0, v[2] * c1 - v[3] * s1, v[3] * c1 + v[2] * s1};
}

struct EpiLat {
    bf16_t* LAT; bf16_t* KR; const float* cosM; const float* sinM; float* SSQP;
    static constexpr bool HAS_PRE = false;
    DI void pre(int) const {}
    DI void operator()(const f32x4 (&acc)[2][2][4][2], int pm, int pn, int wr, int wc, int fr, int fq) const {
        EPI_LOOP_BEGIN
            if (col < 640) st_bf4(LAT + (size_t)row * 640 + col, v);
            else if (col < 704) { const int i0 = (col - 640) >> 1; st_bf4(KR + (size_t)row * 64 + (col - 640), rope4(v, cosM + row * 32 + i0, sinM + row * 32 + i0)); }
        EPI_LOOP_END
#pragma unroll
        for (int ai = 0; ai < 2; ++ai)
#pragma unroll
            for (int m = 0; m < 4; ++m) {
                const int row = pm * BM + ai * HALF + wr * 64 + m * 16 + fr;
#pragma unroll
                for (int bj = 0; bj < 2; ++bj) {
                    const f32x4 a = acc[ai][bj][m][0], b = acc[ai][bj][m][1];
                    float s = (a[0] * a[0] + a[1] * a[1]) + (a[2] * a[2] + a[3] * a[3]) + (b[0] * b[0] + b[1] * b[1]) + (b[2] * b[2] + b[3] * b[3]);
                    s += __shfl_xor(s, 16); s += __shfl_xor(s, 32);
                    const int g = pn * 8 + bj * 4 + wc;
                    if (fq == 0 && g < 20) SSQP[(size_t)row * 24 + g] = s;
                }
            }
    }
};
constexpr float QSCALE_A = 0.10411754627697264f;
constexpr float QSCALE_B = 0.12751743082459868f;
template <int G0, int NG> DI void rs_pre(const float* SSQP, int pm) {
    float* rs = (float*)(g_lds + 131072);
    int tid = threadIdx.x; asm volatile("" : "+v"(tid));
    if (tid < 256) {
        const float* p = SSQP + (size_t)(pm * BM + tid) * 24 + G0;
        float ss = 0.f;
#pragma unroll
        for (int i = 0; i < NG / 4; ++i) { const f32x4 v = *(const f32x4*)(p + 4 * i); ss += (v[0] + v[1]) + (v[2] + v[3]); }
        rs[tid] = rsqrtf(ss * (1.0f / (NG * 32)) + 1e-6f);
    }
}
struct EpiQ {
    const float* SSQP; bf16_t* Q; const float* cosM; const float* sinM;
    static constexpr bool HAS_PRE = true;
    DI void pre(int pm) const { rs_pre<0, 12>(SSQP, pm); }
    DI void operator()(const f32x4 (&acc)[2][2][4][2], int pm, int pn, int wr, int wc, int fr, int fq) const {
        int fro = wr * 64 + fr; asm volatile("" : "+v"(fro));
        const float* rs = (const float*)(g_lds + 131072) + fro;
        EPI_LOOP_BEGIN
            v = v * (rs[ai * HALF + m * 16] * QSCALE_A);
            const int c = col % 192;
            if (c >= 128) { const int i0 = (c - 128) >> 1; v = rope4(v, cosM + row * 32 + i0, sinM + row * 32 + i0); }
            st_bf4(Q + (size_t)row * 1536 + col, v);
            if (bj == 1 && n == 1) __builtin_amdgcn_sched_barrier(0);
        EPI_LOOP_END
    }
};
struct EpiKV {
    const float* SSQP; bf16_t* KV;
    static constexpr bool HAS_PRE = true;
    DI void pre(int pm) const { rs_pre<12, 8>(SSQP, pm); }
    DI void operator()(const f32x4 (&acc)[2][2][4][2], int pm, int pn, int wr, int wc, int fr, int fq) const {
        int fro = wr * 64 + fr; asm volatile("" : "+v"(fro));
        const float* rs = (const float*)(g_lds + 131072) + fro;
        EPI_LOOP_BEGIN
            v = v * rs[ai * HALF + m * 16];
            st_bf4(KV + (size_t)row * 2048 + col, v);
            if (bj == 1 && n == 1) __builtin_amdgcn_sched_barrier(0);
        EPI_LOOP_END
    }
};
struct EpiRes {
    const float* R; float* Y;
    static constexpr bool HAS_PRE = false;
    DI void pre(int) const {}
    DI void operator()(const f32x4 (&acc)[2][2][4][2], int pm, int pn, int wr, int wc, int fr, int fq) const {
        EPI_LOOP_BEGIN
            const f32x4 r = *(const f32x4*)(R + (size_t)row * DM + col);
            *(f32x4*)(Y + (size_t)row * DM + col) = r * 1.4142135623730951f + v;
        EPI_LOOP_END
    }
};
struct EpiSwiglu {
    bf16_t* H;
    static constexpr bool HAS_PRE = false;
    DI void pre(int) const {}
    DI void operator()(const f32x4 (&acc)[2][2][4][2], int pm, int pn, int wr, int wc, int fr, int fq) const {
#pragma unroll
        for (int ai = 0; ai < 2; ++ai)
#pragma unroll
            for (int m = 0; m < 4; ++m) {
                const int row = pm * BM + ai * HALF + wr * 64 + m * 16 + fr;
#pragma unroll
                for (int bj = 0; bj < 2; ++bj) {
                    const f32x4 g = acc[ai][bj][m][0], u = acc[ai][bj][m][1];
                    f32x4 h;
#pragma unroll
                    for (int j = 0; j < 4; ++j) h[j] = g[j] * __builtin_amdgcn_rcpf(1.0f + __builtin_amdgcn_exp2f(-1.4426950408889634f * g[j])) * u[j];
                    st_bf4(H + (size_t)row * DFF + pn * 128 + bj * 64 + wc * 16 + fq * 4, h);
                }
            }
    }
};
struct EpiMobaQKV {
    bf16_t* QKV; const float* cosB; const float* sinB;
    static constexpr bool HAS_PRE = false;
    DI void pre(int) const {}
    DI void operator()(const f32x4 (&acc)[2][2][4][2], int pm, int pn, int wr, int wc, int fr, int fq) const {
        EPI_LOOP_BEGIN
            if (col < 2048) { const int c = col & 127; if (c < 32) { const int i0 = c >> 1; v = rope4(v, cosB + row * 16 + i0, sinB + row * 16 + i0); } }
            if (col < 1024) v = v * QSCALE_B;
            st_bf4(QKV + (size_t)row * 3072 + col, v);
        EPI_LOOP_END
    }
};

constexpr int AL_K0 = 0, AL_KB = 24576, AL_V0 = 49152, AL_VB = 16384, AL_W = 81920;
#define MFMA32(a, b, c) __builtin_amdgcn_mfma_f32_32x32x16_bf16((a), (b), (c), 0, 0, 0)
DI void dma16(const void* g, unsigned ldsoff) {
    __builtin_amdgcn_global_load_lds((const unsigned*)g, (LAS unsigned*)((LAS unsigned char*)g_lds + ldsoff), 16, 0, 0);
}
DI bf16x8 pack8(const f32x16& x, int s) {
    u32x4 w = {cvtpk(x[8 * s], x[8 * s + 1]), cvtpk(x[8 * s + 2], x[8 * s + 3]), cvtpk(x[8 * s + 4], x[8 * s + 5]), cvtpk(x[8 * s + 6], x[8 * s + 7])};
    return __builtin_bit_cast(bf16x8, w);
}
template <int ND> struct KBase { int b[ND == 12 ? 4 : 8]; };
template <int ND> DI KBase<ND> make_kbase(int r32, int hi) {
    KBase<ND> k;
    if constexpr (ND == 12) {
#pragma unroll
        for (int dd = 0; dd < 4; ++dd) k.b[dd] = r32 * 384 + (((dd * 2 + hi) ^ ((r32 >> 1) & 7)) << 4);
    } else {
#pragma unroll
        for (int dd = 0; dd < 8; ++dd) k.b[dd] = r32 * 256 + (((dd * 2 + hi) ^ (r32 & 15)) << 4);
    }
    return k;
}
DI unsigned v_lane_base(int lane) {
    const int i16 = lane & 15, g = lane >> 4, rowq = i16 >> 2, pp = i16 & 3, colblk = g & 1, hi = g >> 1;
    return (unsigned)(hi * 1024 + rowq * 64 + colblk * 32 + pp * 8);
}
template <int ND>
DI void attn_tile(int kbuf_off, unsigned vb, const KBase<ND>& kb, const bf16x8* qr, f32x16 (&o)[4], float& m, float& l, bool domask, int qrel, float* alw, int r32, int hi) {
    f32x16 p0 = {}, p1 = {};
    constexpr int RS = (ND == 12) ? 384 : 256;
    const unsigned char* kbuf = g_lds + kbuf_off;
#pragma unroll
    for (int dg = 0; dg < ND / 2; ++dg) {
        bf16x8 b0[2], b1[2];
#pragma unroll
        for (int i = 0; i < 2; ++i) {
            const int d0 = dg * 2 + i;
            const unsigned char* a = (ND == 12) ? (kbuf + kb.b[d0 & 3] + (d0 >> 2) * 128) : (kbuf + kb.b[d0 & 7]);
            b0[i] = *(const bf16x8*)a; b1[i] = *(const bf16x8*)(a + 32 * RS);
        }
#pragma unroll
        for (int i = 0; i < 2; ++i) { p0 = MFMA32(b0[i], qr[dg * 2 + i], p0); p1 = MFMA32(b1[i], qr[dg * 2 + i], p1); }
        __builtin_amdgcn_sched_barrier(0);
    }
    if (domask) {
        const float NEG = -__builtin_inff();
#pragma unroll
        for (int r = 0; r < 16; ++r) { const int k0 = (r & 3) + 8 * (r >> 2) + 4 * hi; if (k0 > qrel) p0[r] = NEG; if (k0 + 32 > qrel) p1[r] = NEG; }
    }
    float mx = p0[0];
#pragma unroll
    for (int r = 1; r < 16; ++r) mx = fmaxf(mx, p0[r]);
#pragma unroll
    for (int r = 0; r < 16; ++r) mx = fmaxf(mx, p1[r]);
    mx = fmaxf(mx, __shfl_xor(mx, 32));
    if (!__all(mx - m <= 11.0f)) {
        const float mn = fmaxf(m, mx);
        const float alpha = __builtin_amdgcn_exp2f(m - mn);
        m = mn; l *= alpha;
        if (hi == 0) alw[r32] = alpha;
        asm volatile("s_waitcnt lgkmcnt(0)" ::: "memory");
#pragma unroll
        for (int r = 0; r < 16; ++r) { const float a = alw[crow(r, hi)];
#pragma unroll
            for (int d0 = 0; d0 < 4; ++d0) o[d0][r] *= a; }
        asm volatile("s_waitcnt lgkmcnt(0)" ::: "memory");
    }
    float ps = 0.f;
#pragma unroll
    for (int r = 0; r < 16; ++r) { p0[r] = __builtin_amdgcn_exp2f(p0[r] - m); ps += p0[r]; }
#pragma unroll
    for (int r = 0; r < 16; ++r) { p1[r] = __builtin_amdgcn_exp2f(p1[r] - m); ps += p1[r]; }
    l += ps;
    const bf16x8 pa0 = pack8(p0, 0), pa1 = pack8(p0, 1), pa2 = pack8(p1, 0), pa3 = pack8(p1, 1);
#define TRRD(dst, off) asm volatile("ds_read_b64_tr_b16 %0, %1 offset:%2" : "=&v"(dst) : "v"(vb), "i"(off) : "memory")
#define PV_D0(d0) do { s16x4 l0, l1, h0, h1; constexpr int b_ = (d0) * 256; \
        TRRD(l0, b_); TRRD(h0, b_ + 2048); TRRD(l1, b_ + 4096); TRRD(h1, b_ + 6144); \
        asm volatile("s_waitcnt lgkmcnt(0)" ::: "memory"); __builtin_amdgcn_sched_barrier(0); \
        o[d0] = MFMA32(pa0, ((bf16x8){l0[0], l0[1], l0[2], l0[3], h0[0], h0[1], h0[2], h0[3]}), o[d0]); \
        o[d0] = MFMA32(pa1, ((bf16x8){l1[0], l1[1], l1[2], l1[3], h1[0], h1[1], h1[2], h1[3]}), o[d0]); \
        TRRD(l0, b_ + 8192); TRRD(h0, b_ + 10240); TRRD(l1, b_ + 12288); TRRD(h1, b_ + 14336); \
        asm volatile("s_waitcnt lgkmcnt(0)" ::: "memory"); __builtin_amdgcn_sched_barrier(0); \
        o[d0] = MFMA32(pa2, ((bf16x8){l0[0], l0[1], l0[2], l0[3], h0[0], h0[1], h0[2], h0[3]}), o[d0]); \
        o[d0] = MFMA32(pa3, ((bf16x8){l1[0], l1[1], l1[2], l1[3], h1[0], h1[1], h1[2], h1[3]}), o[d0]); } while (0)
    PV_D0(0); PV_D0(1); PV_D0(2); PV_D0(3);
#undef PV_D0
#undef TRRD
}
#define VM_DRAIN() asm volatile("s_waitcnt vmcnt(0)" ::: "memory")

DI void mla_block(const bf16_t* __restrict__ Q, const bf16_t* __restrict__ KV, const bf16_t* __restrict__ KR, bf16_t* __restrict__ AO, int h, int qb) {
    int tid = threadIdx.x; asm volatile("" : "+v"(tid));
    const int w = __builtin_amdgcn_readfirstlane(tid >> 6), lane = tid & 63, r32 = lane & 31, hi = lane >> 5;
    float* alw = (float*)(g_lds + AL_W + w * 512);
    const int NT = 4 * qb + 4, tmax = 4 * qb + (w >> 1);
    const int row = qb * 256 + w * 32 + r32;
    bf16x8 qr[12];
    { const bf16_t* qp = Q + (size_t)row * 1536 + h * 192 + hi * 8;
#pragma unroll
      for (int d0 = 0; d0 < 12; ++d0) qr[d0] = *(const bf16x8*)(qp + d0 * 16); }
    int ksrc[3], vsrc[2];
#pragma unroll
    for (int i = 0; i < 3; ++i) { const int b = (i * 8 + w) * 1024 + lane * 16, kr = b / 384, pc = (b - kr * 384) >> 4, c = pc ^ ((kr >> 1) & 7);
        ksrc[i] = (c < 16) ? (kr * 2048 + h * 256 + c * 8) : -(kr * 64 + (c - 16) * 8) - 1; }
#pragma unroll
    for (int i = 0; i < 2; ++i) { const int key = (i * 8 + w) * 4 + ((lane >> 2) & 3), col = (lane >> 4) * 32 + (lane & 3) * 8; vsrc[i] = key * 2048 + h * 256 + 128 + col; }
#define MLA_ISSUE(t_, b_) do { const bf16_t* kvb_ = KV + (size_t)(t_) * 64 * 2048; const bf16_t* krb_ = KR + (size_t)(t_) * 64 * 64; \
    _Pragma("unroll") for (int i = 0; i < 3; ++i) dma16((ksrc[i] >= 0) ? (const void*)(kvb_ + ksrc[i]) : (const void*)(krb_ + (-ksrc[i] - 1)), AL_K0 + (b_) * AL_KB + (i * 8 + w) * 1024); \
    _Pragma("unroll") for (int i = 0; i < 2; ++i) dma16(kvb_ + vsrc[i], AL_V0 + (b_) * AL_VB + (i * 8 + w) * 1024); } while (0)
    f32x16 o[4] = {};
    float m = -1e30f, l = 0.f;
    const unsigned vb0 = (unsigned)(uintptr_t)(g_lds + AL_V0) + v_lane_base(lane);
    const KBase<12> kb = make_kbase<12>(r32, hi);
    MLA_ISSUE(0, 0); VM_DRAIN();
    __syncthreads();
#pragma unroll 1
    for (int t = 0; t < NT; ++t) {
        const int b = t & 1;
        if (t + 1 < NT) MLA_ISSUE(t + 1, b ^ 1);
        if (t <= tmax) attn_tile<12>(AL_K0 + b * AL_KB, vb0 + b * AL_VB, kb, qr, o, m, l, t == tmax, row - t * 64, alw, r32, hi);
        VM_DRAIN();
        __syncthreads();
    }
#undef MLA_ISSUE
    const float lt = l + __shfl_xor(l, 32);
    if (hi == 0) alw[r32] = __builtin_amdgcn_rcpf(lt);
    asm volatile("s_waitcnt lgkmcnt(0)" ::: "memory");
    bf16_t* Ow = AO + (size_t)(qb * 256 + w * 32) * 1024 + h * 128;
#pragma unroll
    for (int r = 0; r < 16; ++r) { const int orow = crow(r, hi); const float inv = alw[orow];
#pragma unroll
        for (int d0 = 0; d0 < 4; ++d0) { const float v = o[d0][r] * inv; const float vn = __shfl_xor(v, 1);
            if ((r32 & 1) == 0) *(unsigned*)(Ow + (size_t)orow * 1024 + d0 * 32 + r32) = cvtpk(v, vn); } }
    asm volatile("s_waitcnt lgkmcnt(0)" ::: "memory");
}
DI void mla_attn_phase(const Params& P) {
    const bf16_t* Q = (const bf16_t*)(P.ws + WS_Q); const bf16_t* KV = (const bf16_t*)(P.ws + WS_KV); const bf16_t* KR = (const bf16_t*)(P.ws + WS_KR);
    bf16_t* AO = (bf16_t*)(P.ws + WS_AO);
    for (int item = blockIdx.x; item < 256; item += gridDim.x) {
        const int h = item & 7, p = item >> 3;
#pragma unroll 1
        for (int sub = 0; sub < 2; ++sub) mla_block(Q, KV, KR, AO, h, sub ? p : 63 - p);
    }
}

DI void moba_kmean_phase(const Params& P) {
    const bf16_t* QKV = (const bf16_t*)(P.ws + WS_QKV); bf16_t* KMH = (bf16_t*)(P.ws + WS_KMH); bf16_t* KML = (bf16_t*)(P.ws + WS_KML);
    float* red = (float*)g_lds;
    const int tid = threadIdx.x, d = tid & 127, part = tid >> 7;
    for (int item = blockIdx.x; item < 512; item += gridDim.x) {
        const int h = item >> 6, j = item & 63;
        const bf16_t* kp = QKV + (size_t)(j * 256 + part * 64) * 3072 + 1024 + h * 128 + d;
        float s = 0.f;
        for (int i = 0; i < 64; ++i) s += bf2f(kp[(size_t)i * 3072]);
        __syncthreads();
        red[tid] = s;
        __syncthreads();
        if (tid < 128) {
            const float km = ((red[tid] + red[tid + 128]) + (red[tid + 256] + red[tid + 384])) * (1.0f / 256.0f);
            const unsigned hb = cvtpk(km, 0.f) & 0xffffu; const float hf = bf2f((unsigned short)hb);
            const unsigned lb = cvtpk(km - hf, 0.f) & 0xffffu;
            KMH[item * 128 + tid] = (bf16_t)hb; KML[item * 128 + tid] = (bf16_t)lb;
        }
    }
}
#define TOP3_INS(v_, i_) do { const float vv_ = (v_); const int ii_ = (i_); \
    if (vv_ > v1 || (vv_ == v1 && ii_ < i1)) { v3 = v2; i3 = i2; v2 = v1; i2 = i1; v1 = vv_; i1 = ii_; } \
    else if (vv_ > v2 || (vv_ == v2 && ii_ < i2)) { v3 = v2; i3 = i2; v2 = vv_; i2 = ii_; } \
    else if (vv_ > v3 || (vv_ == v3 && ii_ < i3)) { v3 = vv_; i3 = ii_; } } while (0)
DI void moba_gate_phase(const Params& P) {
    const bf16_t* QKV = (const bf16_t*)(P.ws + WS_QKV); const bf16_t* KMH = (const bf16_t*)(P.ws + WS_KMH); const bf16_t* KML = (const bf16_t*)(P.ws + WS_KML);
    unsigned* cnt = (unsigned*)(P.ws + WS_CTL) + CTL_CNT; unsigned short* list = (unsigned short*)(P.ws + WS_LIST); float2* ML = (float2*)(P.ws + WS_ML);
    const int tid = threadIdx.x, w = tid >> 6, lane = tid & 63, r32 = lane & 31, hi = lane >> 5;
    unsigned* lcnt = (unsigned*)g_lds; unsigned* lbase = lcnt + 64;
    for (int item = blockIdx.x; item < 512; item += gridDim.x) {
        const int h = item & 7, tq = item >> 3;
        const int q = tq * 256 + w * 32 + r32;
        float v1 = -3e38f, v2 = -3e38f, v3 = -3e38f; int i1 = 255, i2 = 255, i3 = 255;
        if (tq > 0) {
            bf16x8 qr[8];
            { const bf16_t* qp = QKV + (size_t)q * 3072 + h * 128 + hi * 8;
#pragma unroll
              for (int d0 = 0; d0 < 8; ++d0) qr[d0] = *(const bf16x8*)(qp + d0 * 16); }
#pragma unroll
            for (int u = 0; u < 2; ++u) {
                if (32 * u < tq) {
                    f32x16 g = {};
                    const size_t ko = (size_t)((h * 64 + 32 * u + r32) * 128 + hi * 8);
#pragma unroll
                    for (int d0 = 0; d0 < 8; ++d0) {
                        g = MFMA32(*(const bf16x8*)(KMH + ko + d0 * 16), qr[d0], g);
                        g = MFMA32(*(const bf16x8*)(KML + ko + d0 * 16), qr[d0], g);
                    }
#pragma unroll
                    for (int r = 0; r < 16; ++r) { const int blk = 32 * u + crow(r, hi); if (blk < tq) TOP3_INS(g[r], blk); }
                }
            }
            const float pv1 = __shfl_xor(v1, 32), pv2 = __shfl_xor(v2, 32), pv3 = __shfl_xor(v3, 32);
            const int pi1 = __shfl_xor(i1, 32), pi2 = __shfl_xor(i2, 32), pi3 = __shfl_xor(i3, 32);
            if (pi1 < 255) TOP3_INS(pv1, pi1);
            if (pi2 < 255) TOP3_INS(pv2, pi2);
            if (pi3 < 255) TOP3_INS(pv3, pi3);
        }
        __syncthreads();
        if (tid < 64) { lcnt[tid] = 0u; }
        __syncthreads();
        const int sel[3] = {i1, i2, i3};
        unsigned lpos[3] = {0u, 0u, 0u};
        if (hi == 0) {
#pragma unroll
            for (int s = 0; s < 3; ++s) {
                if (sel[s] < 255) lpos[s] = atomicAdd(&lcnt[sel[s]], 1u);
                else ML[(size_t)(q * 8 + h) * 3 + s] = make_float2(-1e30f, 0.f);
            }
        }
        __syncthreads();
        if (tid < 64) { const unsigned c = lcnt[tid]; lbase[tid] = c ? atomicAdd(&cnt[h * 64 + tid], c) : 0u; }
        __syncthreads();
        if (hi == 0) {
#pragma unroll
            for (int s = 0; s < 3; ++s)
                if (sel[s] < 255) list[(size_t)(h * 64 + sel[s]) * 16384 + lbase[sel[s]] + lpos[s]] = (unsigned short)((q << 2) | s);
        }
    }
}
#define MB_DECL int mb_k[2], mb_v[2]; \
    _Pragma("unroll") for (int i = 0; i < 2; ++i) { const int kr_ = (i * 8 + w) * 4 + (lane >> 4), c_ = (lane & 15) ^ (kr_ & 15); mb_k[i] = kr_ * 3072 + 1024 + c_ * 8; \
        const int key_ = (i * 8 + w) * 4 + ((lane >> 2) & 3), col_ = (lane >> 4) * 32 + (lane & 3) * 8; mb_v[i] = key_ * 3072 + 2048 + col_; }
#define MB_ISSUE(key0_, b_) do { const bf16_t* g_ = QKV + (size_t)(key0_) * 3072 + h * 128; \
    _Pragma("unroll") for (int i = 0; i < 2; ++i) { dma16(g_ + mb_k[i], AL_K0 + (b_) * AL_KB + (i * 8 + w) * 1024); dma16(g_ + mb_v[i], AL_V0 + (b_) * AL_VB + (i * 8 + w) * 1024); } } while (0)

DI void moba_sel_phase(const Params& P) {
    const bf16_t* QKV = (const bf16_t*)(P.ws + WS_QKV);
    const unsigned* cnt = (const unsigned*)(P.ws + WS_CTL) + CTL_CNT; const unsigned short* list = (const unsigned short*)(P.ws + WS_LIST);
    float2* ML = (float2*)(P.ws + WS_ML); bf16_t* PART = (bf16_t*)(P.ws + WS_PART);
    const int tid = threadIdx.x, w = __builtin_amdgcn_readfirstlane(tid >> 6), lane = tid & 63, r32 = lane & 31, hi = lane >> 5;
    int* pre = (int*)(g_lds + 100 * 1024);
    float* alw = (float*)(g_lds + AL_W + w * 512);
    unsigned* cdw = (unsigned*)(alw + 32);
    __syncthreads();
    pre[tid + 1] = (int)((__hip_atomic_load(cnt + tid, __ATOMIC_RELAXED, __HIP_MEMORY_SCOPE_AGENT) + 255u) >> 8);
    __syncthreads();
    if (tid == 0) { int a = 0; pre[0] = 0; for (int i = 1; i <= 512; ++i) { a += pre[i]; pre[i] = a; } }
    __syncthreads();
    const int T = pre[512];
    const unsigned vb0 = (unsigned)(uintptr_t)(g_lds + AL_V0) + v_lane_base(lane);
    const KBase<8> kb = make_kbase<8>(r32, hi);
    MB_DECL;
    for (int cid = blockIdx.x; cid < T; cid += gridDim.x) {
        int lo = 0, hi_ = 512;
        while (hi_ - lo > 1) { const int mid = (lo + hi_) >> 1; if (pre[mid] <= cid) lo = mid; else hi_ = mid; }
        const int hj = lo, h = hj >> 6, j = hj & 63, c = cid - pre[hj];
        const int n = (int)__hip_atomic_load(cnt + hj, __ATOMIC_RELAXED, __HIP_MEMORY_SCOPE_AGENT);
        const int e0 = c * 256 + w * 32;
        const bool wact = e0 < n;
        const bool valid = (e0 + r32) < n;
        const unsigned code = list[(size_t)hj * 16384 + (valid ? (e0 + r32) : (wact ? e0 : 0))];
        const int q = (int)(code >> 2), slot = (int)(code & 3);
        bf16x8 qr[8];
        { const bf16_t* qp = QKV + (size_t)q * 3072 + h * 128 + hi * 8;
#pragma unroll
          for (int d0 = 0; d0 < 8; ++d0) qr[d0] = *(const bf16x8*)(qp + d0 * 16); }
        f32x16 o[4] = {};
        float m = -1e30f, l = 0.f;
        MB_ISSUE(j * 256, 0); VM_DRAIN();
        __syncthreads();
#pragma unroll 1
        for (int t = 0; t < 4; ++t) {
            const int b = t & 1;
            if (t + 1 < 4) MB_ISSUE(j * 256 + (t + 1) * 64, b ^ 1);
            if (wact) attn_tile<8>(AL_K0 + b * AL_KB, vb0 + b * AL_VB, kb, qr, o, m, l, false, 0, alw, r32, hi);
            VM_DRAIN();
            __syncthreads();
        }
        if (wact) {
            const float lt = l + __shfl_xor(l, 32);
            if (hi == 0) { alw[r32] = __builtin_amdgcn_rcpf(lt); cdw[r32] = valid ? code : 0xffffffffu; if (valid) ML[(size_t)(q * 8 + h) * 3 + slot] = make_float2(m, lt); }
            asm volatile("s_waitcnt lgkmcnt(0)" ::: "memory");
#pragma unroll
            for (int r = 0; r < 16; ++r) { const int orow = crow(r, hi); const float inv = alw[orow]; const unsigned cd = cdw[orow];
                bf16_t* dst = PART + ((size_t)((cd >> 2) * 3 + (cd & 3)) * 8 + h) * 128;
#pragma unroll
                for (int d0 = 0; d0 < 4; ++d0) { const float v = o[d0][r] * inv; const float vn = __shfl_xor(v, 1);
                    if ((r32 & 1) == 0 && cd != 0xffffffffu) *(unsigned*)(dst + d0 * 32 + r32) = cvtpk(v, vn); } }
            asm volatile("s_waitcnt lgkmcnt(0)" ::: "memory");
        }
    }
}
DI void moba_own_phase(const Params& P) {
    bf16_t* QKV = (bf16_t*)(P.ws + WS_QKV);
    const float2* ML = (const float2*)(P.ws + WS_ML); const bf16_t* PART = (const bf16_t*)(P.ws + WS_PART);
    const int tid = threadIdx.x, w = __builtin_amdgcn_readfirstlane(tid >> 6), lane = tid & 63, r32 = lane & 31, hi = lane >> 5;
    float* alw = (float*)(g_lds + AL_W + w * 512);
    const unsigned vb0 = (unsigned)(uintptr_t)(g_lds + AL_V0) + v_lane_base(lane);
    const KBase<8> kb = make_kbase<8>(r32, hi);
    MB_DECL;
    for (int item = blockIdx.x; item < 512; item += gridDim.x) {
        const int h = item & 7, tq = item >> 3;
        const int q = tq * 256 + w * 32 + r32;
        bf16x8 qr[8];
        { const bf16_t* qp = QKV + (size_t)q * 3072 + h * 128 + hi * 8;
#pragma unroll
          for (int d0 = 0; d0 < 8; ++d0) qr[d0] = *(const bf16x8*)(qp + d0 * 16); }
        f32x16 o[4] = {};
        float m = -1e30f, l = 0.f;
        const int tmax = w >> 1;
        MB_ISSUE(tq * 256, 0); VM_DRAIN();
        __syncthreads();
#pragma unroll 1
        for (int t = 0; t < 4; ++t) {
            const int b = t & 1;
            if (t + 1 < 4) MB_ISSUE(tq * 256 + (t + 1) * 64, b ^ 1);
            if (t <= tmax) attn_tile<8>(AL_K0 + b * AL_KB, vb0 + b * AL_VB, kb, qr, o, m, l, t == tmax, w * 32 + r32 - t * 64, alw, r32, hi);
            VM_DRAIN();
            __syncthreads();
        }
        const float lt = l + __shfl_xor(l, 32);
        const float2* mlp = ML + (size_t)(q * 8 + h) * 3;
        const float2 a0 = mlp[0], a1 = mlp[1], a2 = mlp[2];
        const float M = fmaxf(fmaxf(m, a0.x), fmaxf(a1.x, a2.x));
        const float wo = __builtin_amdgcn_exp2f(m - M);
        const float w0 = a0.y > 0.f ? a0.y * __builtin_amdgcn_exp2f(a0.x - M) : 0.f;
        const float w1 = a1.y > 0.f ? a1.y * __builtin_amdgcn_exp2f(a1.x - M) : 0.f;
        const float w2 = a2.y > 0.f ? a2.y * __builtin_amdgcn_exp2f(a2.x - M) : 0.f;
        const float inv = __builtin_amdgcn_rcpf(lt * wo + w0 + w1 + w2);
        if (hi == 0) { alw[r32] = wo * inv; alw[32 + r32] = w0 * inv; alw[64 + r32] = w1 * inv; alw[96 + r32] = w2 * inv; }
        asm volatile("s_waitcnt lgkmcnt(0)" ::: "memory");
        float* ob = (float*)g_lds + w * (32 * 68);
        const int rr = lane >> 1, cs = (lane & 1) * 32;
        const float c1 = alw[32 + rr], c2 = alw[64 + rr], c3 = alw[96 + rr];
        bf16_t* Ow = QKV + (size_t)(tq * 256 + w * 32 + rr) * 3072 + h * 128 + cs;
        const bf16_t* pp = PART + ((size_t)(tq * 256 + w * 32 + rr) * 24 + h) * 128 + cs;
#pragma unroll
        for (int half = 0; half < 2; ++half) {
#pragma unroll
            for (int r = 0; r < 16; ++r) { const int orow = crow(r, hi); const float c0 = alw[orow];
                ob[orow * 68 + r32] = o[2 * half][r] * c0; ob[orow * 68 + 32 + r32] = o[2 * half + 1][r] * c0; }
            asm volatile("s_waitcnt lgkmcnt(0)" ::: "memory");
            bf16x8 s0[4], s1[4], s2[4];
#pragma unroll
            for (int i = 0; i < 4; ++i) { s0[i] = *(const bf16x8*)(pp + half * 64 + i * 8); s1[i] = *(const bf16x8*)(pp + 1024 + half * 64 + i * 8); s2[i] = *(const bf16x8*)(pp + 2048 + half * 64 + i * 8); }
#pragma unroll
            for (int i = 0; i < 4; ++i) {
                const f32x4 a = *(const f32x4*)(ob + rr * 68 + cs + i * 8), bq = *(const f32x4*)(ob + rr * 68 + cs + i * 8 + 4);
                float v[8] = {a[0], a[1], a[2], a[3], bq[0], bq[1], bq[2], bq[3]};
#pragma unroll
                for (int j = 0; j < 8; ++j) {
                    v[j] += (c1 > 0.f) ? c1 * bf2f((unsigned short)s0[i][j]) : 0.f;
                    v[j] += (c2 > 0.f) ? c2 * bf2f((unsigned short)s1[i][j]) : 0.f;
                    v[j] += (c3 > 0.f) ? c3 * bf2f((unsigned short)s2[i][j]) : 0.f;
                }
                u32x4 wv = {cvtpk(v[0], v[1]), cvtpk(v[2], v[3]), cvtpk(v[4], v[5]), cvtpk(v[6], v[7])};
                *(u32x4*)(Ow + half * 64 + i * 8) = wv;
            }
            asm volatile("s_waitcnt lgkmcnt(0)" ::: "memory");
        }
        __syncthreads();
    }
}

#define XB_TMO      128
#define XB_XCNT(j)  (256  + 64 * (j))
#define XB_XSUB(j)  (1280 + 64 * (j))
#define XB_XGEN(j)  (2304 + 64 * (j))
#define XB_TOP      3328
#define XB_TOPGEN   3392
#define XB_SPIN_CAP (1u << 18)
DI unsigned xb_ld(unsigned* p)              { return __hip_atomic_load(p, __ATOMIC_RELAXED, __HIP_MEMORY_SCOPE_AGENT); }
DI unsigned xb_add(unsigned* p, unsigned v) { return __hip_atomic_fetch_add(p, v, __ATOMIC_RELAXED, __HIP_MEMORY_SCOPE_AGENT); }
DI unsigned xb_xcc_id() { return (unsigned)__builtin_amdgcn_s_getreg((3 << 11) | 20) & 0xFu; }
#define XB_SPIN(cond, bar) do { unsigned _sp = 0; while (cond) { __builtin_amdgcn_s_sleep(1); \
    if ((++_sp & 255u) == 0u) { if (xb_ld(&(bar)[XB_TMO])) break; if (_sp > XB_SPIN_CAP) { atomicAdd(&(bar)[XB_TMO], 1u); break; } } } } while (0)
struct XcdBarrier { unsigned* bar; unsigned x; volatile LAS unsigned* st; };
DI XcdBarrier xcd_barrier_post(unsigned* bar, volatile LAS unsigned* st) {
    XcdBarrier b; b.bar = bar; b.x = xb_xcc_id(); b.st = st;
    if (threadIdx.x == 0) (void)xb_add(&bar[XB_XCNT(b.x)], 1u);
    return b;
}
DI void xcd_barrier_complete(unsigned* bar, unsigned x, unsigned& nloc, unsigned& nx) {
    const unsigned G = gridDim.x * gridDim.y * gridDim.z;
    unsigned sum, cnt, mine, sp = 0u;
    for (;;) {
        sum = 0u; cnt = 0u; mine = 0u;
#pragma unroll
        for (unsigned j = 0; j < 16; ++j) { const unsigned c = xb_ld(&bar[XB_XCNT(j)]); sum += c; cnt += (c > 0u) ? 1u : 0u; mine = (j == x) ? c : mine; }
        if (sum == G) break;
        __builtin_amdgcn_s_sleep(1);
        if ((++sp & 255u) == 0u) { if (xb_ld(&bar[XB_TMO])) break; if (sp > XB_SPIN_CAP) { atomicAdd(&bar[XB_TMO], 1u); break; } }
    }
    nloc = mine > 0u ? mine : 1u; nx = cnt > 0u ? cnt : 1u;
}
DI void xcd_barrier(const XcdBarrier& b) {
    asm volatile("s_waitcnt vmcnt(0)" ::: "memory");
    __syncthreads();
    if (threadIdx.x == 0) {
        unsigned* bar = b.bar;
        __builtin_amdgcn_s_waitcnt(0);
        unsigned nloc = b.st[0], nx = b.st[1];
        if (nloc == 0u) { xcd_barrier_complete(bar, b.x, nloc, nx); b.st[0] = nloc; b.st[1] = nx; }
        const unsigned old = xb_add(&bar[XB_XSUB(b.x)], 1u);
        const unsigned gen = old / nloc;
        if (old + 1u == (gen + 1u) * nloc) {
            __builtin_amdgcn_fence(__ATOMIC_RELEASE, "agent");
            asm volatile("s_waitcnt vmcnt(0)" ::: "memory");
            const unsigned og = xb_add(&bar[XB_TOP], 1u);
            const unsigned tg = og / nx;
            if (og + 1u == (tg + 1u) * nx) xb_add(&bar[XB_TOPGEN], 1u);
            else XB_SPIN(xb_ld(&bar[XB_TOPGEN]) == tg, bar);
            __builtin_amdgcn_fence(__ATOMIC_ACQUIRE, "agent");
            xb_add(&bar[XB_XGEN(b.x)], 1u);
            asm volatile("s_waitcnt vmcnt(0)" ::: "memory");
        } else {
            XB_SPIN(xb_ld(&bar[XB_XGEN(b.x)]) == gen, bar);
            __builtin_amdgcn_fence(__ATOMIC_ACQUIRE, "agent");
            asm volatile("s_waitcnt vmcnt(0)" ::: "memory");
        }
    }
    __syncthreads();
}

constexpr int NPHASE = 19;
__global__ void __launch_bounds__(NTHR) fwd_megakernel(Params P) {
    unsigned char* ws = P.ws;
    const float* cosM = (const float*)(ws + WS_COSM); const float* sinM = (const float*)(ws + WS_SINM);
    const float* cosB = (const float*)(ws + WS_COSB); const float* sinB = (const float*)(ws + WS_SINB);
    bf16_t* XB = (bf16_t*)(ws + WS_XB);
    float* XF = P.out;
    const int lo = P.ph_lo, hi = P.ph_hi;
#define IN(k) (lo <= (k) && (k) < hi)
    volatile LAS unsigned* xst = (volatile LAS unsigned*)((LAS unsigned char*)g_lds + 131072 + 4096);
    if (threadIdx.x < 2) xst[threadIdx.x] = 0u;
    __syncthreads();
    XcdBarrier xbar; xbar.bar = (unsigned*)(ws + WS_CTL) + 4096; xbar.x = 0; xbar.st = xst;
    if (hi - lo > 1) xbar = xcd_barrier_post((unsigned*)(ws + WS_CTL) + 4096, xst);
    if (lo < 0) cg::this_grid().sync();
#define SEAM(k) do { if (IN(k) && IN((k) + 1)) xcd_barrier(xbar); } while (0)
    if (IN(0)) prep_phase(P);
    SEAM(0);
    if (IN(1)) { EpiLat e{(bf16_t*)(ws + WS_LAT), (bf16_t*)(ws + WS_KR), cosM, sinM, P.out  };
        gemm_phase(XB, 1024, (const bf16_t*)(ws + WS_W0_DQKV), 1024, 64, 3, e); }
    SEAM(1);
    if (IN(2)) {
        { EpiQ e{P.out, (bf16_t*)(ws + WS_Q), cosM, sinM};
          gemm_phase((const bf16_t*)(ws + WS_LAT), 640, (const bf16_t*)(ws + WS_W0_UQ), 384, 64, 6, e); }
        { EpiKV e{P.out, (bf16_t*)(ws + WS_KV)};
          gemm_phase((const bf16_t*)(ws + WS_LAT) + 384, 640, (const bf16_t*)(ws + WS_W0_UKV), 256, 64, 8, e, 128); }
    }
    SEAM(2);
    if (IN(3)) mla_attn_phase(P);
    SEAM(3);
    if (IN(4)) { EpiRes e{P.in[0], (float*)(ws + WS_Y)};
        gemm_phase((const bf16_t*)(ws + WS_AO), 1024, (const bf16_t*)(ws + WS_W0_O), 1024, 64, 4, e); }
    SEAM(4);
    if (IN(5)) ln_phase((const float*)(ws + WS_Y), P.in[11], P.in[12], XF, XB);
    SEAM(5);
    if (IN(6)) { EpiSwiglu e{(bf16_t*)(ws + WS_H)};
        gemm_phase(XB, 1024, (const bf16_t*)(ws + WS_W0_IN), 1024, 64, 22, e); }
    SEAM(6);
    if (IN(7)) { EpiRes e{XF, (float*)(ws + WS_Y)};
        gemm_phase((const bf16_t*)(ws + WS_H), DFF, (const bf16_t*)(ws + WS_W0_OUT), DFF, 64, 4, e); }
    SEAM(7);
    if (IN(8)) ln_phase((const float*)(ws + WS_Y), P.in[13], P.in[14], XF, XB);
    SEAM(8);
    if (IN(9)) { EpiMobaQKV e{(bf16_t*)(ws + WS_QKV), cosB, sinB};
        gemm_phase(XB, 1024, (const bf16_t*)(ws + WS_W1_QKV), 1024, 64, 12, e); }
    SEAM(9);
    if (IN(10)) moba_kmean_phase(P);
    SEAM(10);
    if (IN(11)) moba_gate_phase(P);
    SEAM(11);
    if (IN(12)) moba_sel_phase(P);
    SEAM(12);
    if (IN(13)) moba_own_phase(P);
    SEAM(13);
    if (IN(14)) { EpiRes e{XF, (float*)(ws + WS_Y1)};
        gemm_phase((const bf16_t*)(ws + WS_QKV), 3072, (const bf16_t*)(ws + WS_W1_O), 1024, 64, 4, e); }
    SEAM(14);
    if (IN(15)) ln_phase((const float*)(ws + WS_Y1), P.in[11] + DM, P.in[12] + DM, XF, XB);
    SEAM(15);
    if (IN(16)) { EpiSwiglu e{(bf16_t*)(ws + WS_H)};
        gemm_phase(XB, 1024, (const bf16_t*)(ws + WS_W1_IN), 1024, 64, 22, e); }
    SEAM(16);
    if (IN(17)) { EpiRes e{XF, (float*)(ws + WS_Y)};
        gemm_phase((const bf16_t*)(ws + WS_H), DFF, (const bf16_t*)(ws + WS_W1_OUT), DFF, 64, 4, e); }
    SEAM(17);
    if (IN(18)) ln_phase((const float*)(ws + WS_Y), P.in[13] + DM, P.in[14] + DM, XF, nullptr);
#undef IN
#undef SEAM
}

extern "C" void kernel_launch(void* const* d_in, const int* in_sizes, int n_in, void* d_out, int out_size, void* d_ws, size_t ws_size, hipStream_t stream) {
    static int grid = 0;
    if (grid == 0) {
        if (n_in != 15 || out_size != S * DM || ws_size < WS_END) { fprintf(stderr, "kernel_launch: unexpected shapes (n_in %d out %d ws %zu)\n", n_in, out_size, ws_size); grid = -1; return; }
        int dev = 0, cus = 0, per_cu = 0;
        (void)hipGetDevice(&dev);
        (void)hipDeviceGetAttribute(&cus, hipDeviceAttributeMultiprocessorCount, dev);
        (void)hipFuncSetAttribute((const void*)fwd_megakernel, hipFuncAttributeMaxDynamicSharedMemorySize, LDS_BYTES);
        (void)hipOccupancyMaxActiveBlocksPerMultiprocessor(&per_cu, (const void*)fwd_megakernel, NTHR, LDS_BYTES);
        if (per_cu < 1) per_cu = 1;
        grid = cus * per_cu;
        if (grid <= 0) grid = 256;
    }
    if (grid < 0) return;
    (void)hipMemsetAsync((char*)d_ws + WS_CTL, 0, 1 * MiB, stream);
    Params p{};
    for (int i = 0; i < 15; ++i) p.in[i] = (const float*)d_in[i];
    p.out = (float*)d_out; p.ws = (unsigned char*)d_ws;
#if MK_MULTI
    for (int ph = 0; ph < NPHASE; ++ph) {
        p.ph_lo = ph; p.ph_hi = ph + 1;
        for (int rep = 0; rep < (((PROBE_MASK >> ph) & 1u) ? 2 : 1); ++rep)
            hipLaunchKernelGGL(fwd_megakernel, dim3(grid), dim3(NTHR), LDS_BYTES, stream, p);
    }
#else
    p.ph_lo = 0; p.ph_hi = NPHASE;
    void* args[] = {&p};
    hipError_t e = hipLaunchCooperativeKernel((const void*)fwd_megakernel, dim3(grid), dim3(NTHR), args, LDS_BYTES, stream);
    if (e != hipSuccess) fprintf(stderr, "cooperative launch failed: %s (grid %d)\n", hipGetErrorString(e), grid);
#endif
}
```
